# Optimizing an MI355X kernel written in HIP

```python
import jax, jax.numpy as jnp
from jax import lax
import numpy as np

D_MODEL = 1024
BATCH = 8
SEQ = 2048
DEPTH = 2
DEC_BATCH = 128
DEC_SEQ = 1
PAST_LEN = 16384
PAGE_SIZE = 128

N_MIXERS = 2
N_GDN_LAYERS = (DEPTH + 1) // 2
N_POOL_LAYERS = DEPTH // 2
GDN_NK = 8
GDN_NV = 16
GDN_DK = 128
GDN_DV = 128
KEY_DIM = GDN_NK * GDN_DK
VALUE_DIM = GDN_NV * GDN_DV
CONV_W = 4
CONV_DIM = 2 * KEY_DIM + VALUE_DIM
IN_DIM = CONV_DIM + VALUE_DIM + 2 * GDN_NV
CHUNK = 64
POOL_WINDOWS = (2, 4, 8, 16)
POOL_GROUPS = len(POOL_WINDOWS)
POOL_G = D_MODEL // POOL_GROUPS
POOL_BUF = max(POOL_WINDOWS) - 1
D_FF = ((8 * D_MODEL + 3 * 256 - 1) // (3 * 256)) * 256
DN_ALPHA = (2 * DEPTH) ** 0.25
DN_BETA = (8 * DEPTH) ** -0.25
LN_EPS = 1e-5
NORM_EPS = 1e-6

kernel_name = "hybrid_gdn_pool_adaln_deepnorm_step"

F32 = jnp.float32


def layer_norm(x, g, b):
    xf = x.astype(F32)
    mu = jnp.mean(xf, -1, keepdims=True)
    var = jnp.mean(jnp.square(xf - mu), -1, keepdims=True)
    return ((xf - mu) * lax.rsqrt(var + LN_EPS) * g.astype(F32) + b.astype(F32)).astype(x.dtype)


def l2norm(x):
    return x * lax.rsqrt(jnp.sum(jnp.square(x), -1, keepdims=True) + NORM_EPS)


def causal_conv(qkv, prev, w):
    L = qkv.shape[1]
    ext = jnp.concatenate([prev.astype(qkv.dtype), qkv], axis=1)
    y = sum(ext[:, j:j + L] * w[j] for j in range(CONV_W))
    return jax.nn.silu(y), ext[:, L:]


def gated_delta_rule(q, k, v, g, beta, S0):
    B, H, L, DK = q.shape
    DV = v.shape[-1]
    C = min(CHUNK, L)
    pad = (-L) % C
    if pad:
        pw = lambda t: jnp.pad(t, [(0, 0), (0, 0), (0, pad)] + [(0, 0)] * (t.ndim - 3))
        q, k, v, g, beta = pw(q), pw(k), pw(v), pw(g), pw(beta)
    N = (L + pad) // C
    q = q.reshape(B, H, N, C, DK)
    k = k.reshape(B, H, N, C, DK)
    v = v.reshape(B, H, N, C, DV)
    beta = beta.reshape(B, H, N, C)
    g = jnp.cumsum(g.reshape(B, H, N, C), axis=-1)
    tri = jnp.tril(jnp.ones((C, C), bool))
    strict = jnp.tril(jnp.ones((C, C), bool), -1)
    decay = jnp.exp(jnp.where(tri, g[..., :, None] - g[..., None, :], -jnp.inf))
    kb = k * beta[..., None]
    A = jnp.where(strict, jnp.einsum('bhncd,bhnsd->bhncs', kb, k) * decay, 0.0)
    lhs = A + jnp.eye(C, dtype=F32)
    rhs = jnp.concatenate([v * beta[..., None], kb * jnp.exp(g)[..., None]], axis=-1)
    sol = lax.linalg.triangular_solve(lhs, rhs, left_side=True, lower=True)
    value, k_cum = sol[..., :DV], sol[..., DV:]
    attn_local = jnp.where(tri, jnp.einsum('bhncd,bhnsd->bhncs', q, k) * decay, 0.0)
    q_dec = q * jnp.exp(g)[..., None]
    k_dec = k * jnp.exp(g[..., -1:] - g)[..., None]
    g_last = jnp.exp(g[..., -1])

    def step(S, inp):
        qd, kc, val, al, kd, gl = inp
        v_new = val - jnp.einsum('bhcd,bhde->bhce', kc, S)
        o = jnp.einsum('bhcd,bhde->bhce', qd, S) + jnp.einsum('bhcs,bhse->bhce', al, v_new)
        S = S * gl[..., None, None] + jnp.einsum('bhcd,bhce->bhde', kd, v_new)
        return S, o

    mv = lambda t: jnp.moveaxis(t, 2, 0)
    S, o = lax.scan(step, S0, (mv(q_dec), mv(k_cum), mv(value), mv(attn_local), mv(k_dec), mv(g_last)))
    o = jnp.moveaxis(o, 0, 2).reshape(B, H, N * C, DV)[:, :, :L]
    return o, S


def gdn_mixer(u, S0, conv0, w_in, conv_w, A_log, dt_bias, norm_w, w_out):
    B, L, _ = u.shape
    proj = jnp.einsum('bld,de->ble', u, w_in)
    qkv = proj[..., :CONV_DIM]
    z = proj[..., CONV_DIM:CONV_DIM + VALUE_DIM]
    b = proj[..., CONV_DIM + VALUE_DIM:CONV_DIM + VALUE_DIM + GDN_NV]
    a = proj[..., CONV_DIM + VALUE_DIM + GDN_NV:]
    y, conv_new = causal_conv(qkv, conv0, conv_w)
    y = y.astype(F32)
    rep = GDN_NV // GDN_NK
    q = l2norm(y[..., :KEY_DIM].reshape(B, L, GDN_NK, GDN_DK))
    k = l2norm(y[..., KEY_DIM:2 * KEY_DIM].reshape(B, L, GDN_NK, GDN_DK))
    q = jnp.repeat(q, rep, axis=2) * (GDN_DK ** -0.5)
    k = jnp.repeat(k, rep, axis=2)
    v = y[..., 2 * KEY_DIM:].reshape(B, L, GDN_NV, GDN_DV)
    beta = jax.nn.sigmoid(b.astype(F32))
    g = -jnp.exp(A_log.astype(F32)) * jax.nn.softplus(a.astype(F32) + dt_bias.astype(F32))
    th = lambda t: jnp.swapaxes(t, 1, 2)
    o, S = gated_delta_rule(th(q), th(k), th(v), th(g), th(beta), S0.astype(F32))
    o = jnp.swapaxes(o, 1, 2)
    o = o * lax.rsqrt(jnp.mean(jnp.square(o), -1, keepdims=True) + NORM_EPS) * norm_w.astype(F32)
    o = o * jax.nn.silu(z.reshape(B, L, GDN_NV, GDN_DV).astype(F32))
    out = jnp.einsum('blv,vd->bld', o.reshape(B, L, VALUE_DIM).astype(u.dtype), w_out)
    return out, S.astype(S0.dtype), conv_new.astype(conv0.dtype)


def pool_mixer(u, prev, pos0, w_pool, pool_scale):
    B, L, D = u.shape
    uf = u.astype(F32)
    ext = jnp.concatenate([prev.astype(F32), uf], axis=1)
    cs = jnp.concatenate([jnp.zeros((B, 1, D), F32), jnp.cumsum(ext, axis=1)], axis=1)
    end = cs[:, POOL_BUF + 1:]
    pos = pos0 + jnp.arange(L)
    means = []
    for gi, w in enumerate(POOL_WINDOWS):
        sl = slice(gi * POOL_G, (gi + 1) * POOL_G)
        start = cs[:, POOL_BUF + 1 - w:POOL_BUF + 1 - w + L, sl]
        cnt = jnp.minimum(pos + 1, w).astype(F32)[None, :, None]
        means.append((end[..., sl] - start) / cnt)
    pooled = jnp.concatenate(means, axis=-1) - uf
    h = jnp.einsum('blgc,gce->blge', pooled.reshape(B, L, POOL_GROUPS, POOL_G), w_pool.astype(F32))
    h = h.reshape(B, L, D) * pool_scale.astype(F32)
    return h.astype(u.dtype), ext[:, L:].astype(prev.dtype)


def swiglu(u, w_up, w_down):
    h = jnp.einsum('bld,df->blf', u, w_up)
    gt, up = h[..., :D_FF], h[..., D_FF:]
    return jnp.einsum('blf,fd->bld', jax.nn.silu(gt) * up, w_down)


def run_group(x, c, gdn_S, gdn_conv, pool_buf, pos0, ada_w, ada_b, ln_g, ln_b,
              gdn_w_in, gdn_conv_w, gdn_A_log, gdn_dt_bias, gdn_norm_w, gdn_w_out,
              pool_w, pool_scale, ffn_w_up, ffn_w_down):
    mod = jnp.einsum('bd,lde->lbe', jax.nn.silu(c), ada_w) + ada_b[:, None, :]
    y = x
    new_S, new_conv, new_pool = [], [], []
    for i in range(DEPTH):
        sh_m, sc_m, ga_m, sh_f, sc_f, ga_f = jnp.split(mod[i][:, None, :], 6, axis=-1)
        u = y * (1 + sc_m) + sh_m
        j = i // N_MIXERS
        if i % N_MIXERS == 0:
            h, S, cv = gdn_mixer(u, gdn_S[j], gdn_conv[j], gdn_w_in[j], gdn_conv_w[j], gdn_A_log[j],
                                 gdn_dt_bias[j], gdn_norm_w[j], gdn_w_out[j])
            new_S.append(S)
            new_conv.append(cv)
        else:
            h, pb = pool_mixer(u, pool_buf[j], pos0, pool_w[j], pool_scale[j])
            new_pool.append(pb)
        y = layer_norm(DN_ALPHA * y + ga_m * h, ln_g[i, 0], ln_b[i, 0])
        u = y * (1 + sc_f) + sh_f
        y = layer_norm(DN_ALPHA * y + ga_f * swiglu(u, ffn_w_up[i], ffn_w_down[i]), ln_g[i, 1], ln_b[i, 1])
    return y, jnp.stack(new_S), jnp.stack(new_conv), jnp.stack(new_pool)


def setup_inputs(seed: int = 0) -> dict:
    key = jax.random.key(seed)
    ks = jax.random.split(key, 24)
    nrm = lambda k, s, sc: jax.random.normal(k, s, F32) * sc
    D = D_MODEL
    ada_b = jnp.concatenate([
        nrm(ks[5], (DEPTH, 2 * D), 0.02),
        1.0 + nrm(ks[6], (DEPTH, D), 0.02),
        nrm(ks[7], (DEPTH, 2 * D), 0.02),
        1.0 + nrm(ks[8], (DEPTH, D), 0.02)], axis=-1)
    w_in = nrm(ks[9], (N_GDN_LAYERS, D, IN_DIM), D ** -0.5)
    v_cols = (jnp.arange(IN_DIM) >= 2 * KEY_DIM) & (jnp.arange(IN_DIM) < CONV_DIM)
    w_in = w_in * jnp.where(v_cols, DN_BETA, 1.0)
    return {
        "x_prompt": nrm(ks[0], (BATCH, SEQ, D), 1.0),
        "x_sample": nrm(ks[1], (DEC_BATCH, DEC_SEQ, D), 1.0),
        "c_prompt": nrm(ks[2], (BATCH, D), 1.0),
        "c_sample": nrm(ks[3], (DEC_BATCH, D), 1.0),
        "state_gdn_S": nrm(ks[4], (N_GDN_LAYERS, DEC_BATCH, GDN_NV, GDN_DK, GDN_DV), 0.1),
        "state_gdn_conv": nrm(ks[10], (N_GDN_LAYERS, DEC_BATCH, CONV_W - 1, CONV_DIM), 1.0),
        "state_pool": nrm(ks[11], (N_POOL_LAYERS, DEC_BATCH, POOL_BUF, D), 1.0),
        "ada_w": nrm(ks[12], (DEPTH, D, 6 * D), 0.1 * D ** -0.5),
        "ada_b": ada_b,
        "ln_g": 1.0 + nrm(ks[13], (DEPTH, 2, D), 0.02),
        "ln_b": nrm(ks[14], (DEPTH, 2, D), 0.02),
        "gdn_w_in": w_in,
        "gdn_conv_w": nrm(ks[15], (N_GDN_LAYERS, CONV_W, CONV_DIM), CONV_W ** -0.5),
        "gdn_A_log": jnp.log(jax.random.uniform(ks[16], (N_GDN_LAYERS, GDN_NV), F32, 1.0, 16.0)),
        "gdn_dt_bias": nrm(ks[17], (N_GDN_LAYERS, GDN_NV), 0.1),
        "gdn_norm_w": 1.0 + nrm(ks[18], (N_GDN_LAYERS, GDN_DV), 0.02),
        "gdn_w_out": nrm(ks[19], (N_GDN_LAYERS, VALUE_DIM, D), DN_BETA * VALUE_DIM ** -0.5),
        "pool_w": nrm(ks[20], (N_POOL_LAYERS, POOL_GROUPS, POOL_G, POOL_G), DN_BETA * POOL_G ** -0.5),
        "pool_scale": 1.0 + nrm(ks[21], (N_POOL_LAYERS, D), 0.02),
        "ffn_w_up": nrm(ks[22], (DEPTH, D, 2 * D_FF), D ** -0.5),
        "ffn_w_down": nrm(ks[23], (DEPTH, D_FF, D), DN_BETA * D_FF ** -0.5),
    }


def reference(x_prompt, x_sample, c_prompt, c_sample, state_gdn_S, state_gdn_conv, state_pool,
              ada_w, ada_b, ln_g, ln_b, gdn_w_in, gdn_conv_w, gdn_A_log, gdn_dt_bias, gdn_norm_w,
              gdn_w_out, pool_w, pool_scale, ffn_w_up, ffn_w_down):
    B = x_prompt.shape[0]
    dt = x_prompt.dtype
    zS = jnp.zeros((N_GDN_LAYERS, B, GDN_NV, GDN_DK, GDN_DV), dt)
    zC = jnp.zeros((N_GDN_LAYERS, B, CONV_W - 1, CONV_DIM), dt)
    zP = jnp.zeros((N_POOL_LAYERS, B, POOL_BUF, D_MODEL), dt)
    y_prompt, p_S, p_conv, p_pool = run_group(
        x_prompt, c_prompt, zS, zC, zP, 0, ada_w, ada_b, ln_g, ln_b, gdn_w_in, gdn_conv_w,
        gdn_A_log, gdn_dt_bias, gdn_norm_w, gdn_w_out, pool_w, pool_scale, ffn_w_up, ffn_w_down)
    y_sample, s_S, s_conv, s_pool = run_group(
        x_sample, c_sample, state_gdn_S, state_gdn_conv, state_pool, PAST_LEN, ada_w, ada_b, ln_g, ln_b,
        gdn_w_in, gdn_conv_w, gdn_A_log, gdn_dt_bias, gdn_norm_w, gdn_w_out, pool_w, pool_scale,
        ffn_w_up, ffn_w_down)
    return (y_prompt, y_sample, p_S, p_conv, p_pool, s_S, s_conv, s_pool)
```

```cpp
#include <hip/hip_runtime.h>
#include <hip/hip_cooperative_groups.h>
#include <cstdio>
namespace cg = cooperative_groups;

#define LAS __attribute__((address_space(3)))
#define DI __device__ __forceinline__
typedef unsigned short bf16_t;
typedef short bf16x8 __attribute__((ext_vector_type(8)));
typedef float f32x4 __attribute__((ext_vector_type(4)));
typedef float f32x2 __attribute__((ext_vector_type(2)));
typedef unsigned u32x4 __attribute__((ext_vector_type(4)));
typedef unsigned u32x2 __attribute__((ext_vector_type(2)));
typedef __bf16 bf2_t __attribute__((ext_vector_type(2)));

constexpr int D = 1024, TP = 16384, TS = 128, TT = TP + TS, MP = 16640, NBC = 136, SEQ = 2048;
constexpr int NPROJ = 6144, INPAD = 6400, INDIM = 6176, DFF = 2816, CONVD = 4096;
constexpr float DN_ALPHA = 1.4142135623730951f;
constexpr int NTHR = 512;
constexpr int LDS_BYTES = 147456;

constexpr size_t WS_WT_IN = 0;
constexpr size_t WS_WT_OUT = WS_WT_IN + (size_t)INPAD * 1024 * 2;
constexpr size_t WS_WT_UP = WS_WT_OUT + (size_t)1024 * 2048 * 2;
constexpr size_t WS_WT_DOWN = WS_WT_UP + (size_t)2 * 5632 * 1024 * 2;
constexpr size_t WS_WT_POOL = WS_WT_DOWN + (size_t)2 * 1024 * DFF * 2;
constexpr size_t WS_MOD = WS_WT_POOL + (size_t)4 * 256 * 256 * 2;
constexpr size_t WS_BA = WS_MOD + (size_t)2 * NBC * 6144 * 4;
constexpr size_t WS_GC = WS_BA + (size_t)MP * 32 * 4;
constexpr size_t WS_SSQ = WS_GC + (size_t)TP * 16 * 4;
constexpr size_t WS_U = WS_SSQ + (size_t)TP * 16 * 4 * 4;
constexpr size_t WS_PROJ = WS_U + (size_t)MP * 1024 * 2;
constexpr size_t WS_Q = WS_PROJ + (size_t)MP * NPROJ * 2;
constexpr size_t WS_KT = WS_Q + (size_t)TP * 1024 * 2;
constexpr size_t WS_KCUM = WS_KT + (size_t)TP * 1024 * 2;
constexpr size_t WS_VALT = WS_KCUM + (size_t)TP * 2048 * 2;
constexpr size_t WS_END = WS_VALT + (size_t)TP * 2048 * 2;
constexpr size_t WS_R = WS_Q;
static_assert(WS_END <= (size_t)536870912, "workspace");
static_assert((size_t)MP * 1024 * 4 <= WS_END - WS_Q, "R alias");

constexpr size_t O_Y = 0;
constexpr size_t O_PS = (size_t)TT * 1024;
constexpr size_t O_PCONV = O_PS + (size_t)8 * 16 * 16384;
constexpr size_t O_PPOOL = O_PCONV + (size_t)8 * 3 * CONVD;
constexpr size_t O_SS = O_PPOOL + (size_t)8 * 15 * 1024;
constexpr size_t O_SCONV = O_SS + (size_t)128 * 16 * 16384;
constexpr size_t O_SPOOL = O_SCONV + (size_t)128 * 3 * CONVD;

struct Params {
    const float *x_prompt, *x_sample, *c_prompt, *c_sample, *st_S, *st_conv, *st_pool, *ada_w, *ada_b, *ln_g, *ln_b;
    const float *w_in, *conv_w, *A_log, *dt_bias, *norm_w, *w_out, *pool_w, *pool_scale, *w_up, *w_down;
    float* out; unsigned char* ws; int ph_lo, ph_hi;
};

DI unsigned pk2(float a, float b) { f32x2 v = {a, b}; bf2_t r = __builtin_convertvector(v, bf2_t); return __builtin_bit_cast(unsigned, r); }
DI float bflo(unsigned u) { return __uint_as_float(u << 16); }
DI float bfhi(unsigned u) { return __uint_as_float(u & 0xffff0000u); }
DI float silu_f(float x) { return x / (1.f + __expf(-x)); }
DI float sigmoid_f(float x) { return 1.f / (1.f + __expf(-x)); }
DI float softplus_f(float x) { return fmaxf(x, 0.f) + log1pf(__expf(-fabsf(x))); }
DI u32x4 pack8(const float* f) { u32x4 w; w.x = pk2(f[0], f[1]); w.y = pk2(f[2], f[3]); w.z = pk2(f[4], f[5]); w.w = pk2(f[6], f[7]); return w; }
DI void unpack8(u32x4 w, float* f) { f[0] = bflo(w.x); f[1] = bfhi(w.x); f[2] = bflo(w.y); f[3] = bfhi(w.y); f[4] = bflo(w.z); f[5] = bfhi(w.z); f[6] = bflo(w.w); f[7] = bfhi(w.w); }
DI int batch_of(int row) { return row < TP ? (row >> 11) : (8 + row - TP); }
#define MFMA16(a, b, c) __builtin_amdgcn_mfma_f32_16x16x32_bf16((a), (b), (c), 0, 0, 0)

namespace pg8 {
constexpr int BM = 256, BK = 64, HALF = 128, HTB = HALF * BK * 2, STAGE_BYTES = 8 * HTB, NXCD = 8, WGM = 8;
DI int lds_byte(int r, int c) { const int st = (r >> 4) * 2 + (c >> 5), rr = r & 15, cc = c & 31, ob = rr * 64 + cc * 2; return st * 1024 + (ob ^ (((ob >> 9) & 1) << 5)); }
DI void stage_rc(int b, int& R, int& C) { const int st = b / 1024, sb = b % 1024, swz = sb ^ (((sb >> 9) & 1) << 5); R = (st >> 1) * 16 + swz / 64; C = (st & 1) * 32 + (swz % 64) / 2; }
DI int perm32(int rho) { const int n = rho >> 4, i = rho & 15; return 8 * (i >> 2) + 4 * n + (i & 3); }
struct Unit { int pm, pn; };
struct Gemm { const bf16_t* A; const bf16_t* Bt; int lda, ldb, K; int a_pn_off; };
struct StaticOrder {
    int nM, nN, nwg, G, c;
    DI void init(int M, int N, int G_, int c_) { nM = M / BM; nN = N / BM; nwg = nM * nN; G = G_; c = c_; }
    DI bool next(int i, Unit& u) const {
        const long L = (long)i * G + c; if (L >= nwg) return false;
        int wgid = (int)L; { const int q = nwg / NXCD, r = nwg % NXCD, xcd = wgid % NXCD, off = wgid / NXCD; wgid = (xcd < r ? xcd * (q + 1) : r * (q + 1) + (xcd - r) * q) + off; }
        const int nig = WGM * nN, gid = wgid / nig, fm = gid * WGM, gsz = (nM - fm) < WGM ? (nM - fm) : WGM;
        u.pm = fm + ((wgid % nig) % gsz); u.pn = (wgid % nig) / gsz; return true;
    }
};
template <class Epi>
DI void gemm_phase(LAS unsigned char* lds, const Gemm g, const StaticOrder& S, const Epi& E) {
    const int tid = threadIdx.x, wid = __builtin_amdgcn_readfirstlane(tid >> 6), lane = tid & 63, wr = wid >> 2, wc = wid & 3, fr = lane & 15, fq = lane >> 4;
    const int K = g.K, nt = K / BK;
    unsigned voffA[2], voffB[2];
#pragma unroll
    for (int i = 0; i < 2; ++i) { int R, C; stage_rc(tid * 16 + i * 8192, R, C); const int Rb = Epi::PERM ? ((R & ~31) + perm32(R & 31)) : R;
        voffA[i] = (unsigned)(R * g.lda + C) * 2u; voffB[i] = (unsigned)(Rb * g.ldb + C) * 2u; }
    const size_t kstep = (size_t)(BK * 2);
    const size_t hA = (size_t)HALF * g.lda * 2, hB = (size_t)HALF * g.ldb * 2;
    const unsigned ldsw = (unsigned)wid * 1024u;
    const int aoff = lds_byte(wr * 64 + fr, fq * 8), boff = lds_byte(wc * 32 + fr, fq * 8);
#define PG8_SA(b, h) (((b) * 2 + (h)) * HTB)
#define PG8_SB(b, h) ((4 + (b) * 2 + (h)) * HTB)
#define PG8_STAGE(bufoff, gbase, voff) do { _Pragma("unroll") for (int _i = 0; _i < 2; ++_i) \
        __builtin_amdgcn_global_load_lds((const unsigned*)((const char*)(gbase) + (voff)[_i]), (LAS unsigned*)(lds + (bufoff) + ldsw + _i * 8192), 16, 0, 0); } while (0)
#define PG8_LDA(dst, b, h) do { _Pragma("unroll") for (int m = 0; m < 4; ++m) _Pragma("unroll") for (int k = 0; k < 2; ++k) dst[m][k] = *(const LAS bf16x8*)(lds + PG8_SA(b, h) + aoff + m * 2048 + k * 1024); } while (0)
#define PG8_LDB(dst, b, h) do { _Pragma("unroll") for (int n = 0; n < 2; ++n) _Pragma("unroll") for (int k = 0; k < 2; ++k) dst[n][k] = *(const LAS bf16x8*)(lds + PG8_SB(b, h) + boff + n * 2048 + k * 1024); } while (0)
#define PG8_MMA(ai, bj, At, Bt) do { __builtin_amdgcn_s_setprio(1); _Pragma("unroll") for (int m = 0; m < 4; ++m) _Pragma("unroll") for (int n = 0; n < 2; ++n) _Pragma("unroll") for (int k = 0; k < 2; ++k) \
        acc[ai][bj][m][n] = __builtin_amdgcn_mfma_f32_16x16x32_bf16(Bt[n][k], At[m][k], acc[ai][bj][m][n], 0, 0, 0); __builtin_amdgcn_s_setprio(0); } while (0)
#define PG8_WAIT_V(n) asm volatile("s_waitcnt vmcnt(" #n ")" ::: "memory")
#define PG8_WAIT_L(n) asm volatile("s_waitcnt lgkmcnt(" #n ")" ::: "memory")
#define PG8_BAR __builtin_amdgcn_s_barrier()
#define PG8_SCHED __builtin_amdgcn_sched_barrier(0)
    Unit cur, nxt; int ui = 0;
    if (!S.next(0, cur)) return;
    f32x4 acc[2][2][4][2];
#pragma unroll
    for (int a = 0; a < 2; ++a)
#pragma unroll
        for (int b = 0; b < 2; ++b)
#pragma unroll
            for (int m = 0; m < 4; ++m)
#pragma unroll
                for (int n = 0; n < 2; ++n) acc[a][b][m][n] = (f32x4){0.f, 0.f, 0.f, 0.f};
    bf16x8 At[4][2], B0[2][2], B1[2][2];
    const char* cA = (const char*)g.A + (size_t)cur.pm * 2 * hA + (size_t)cur.pn * g.a_pn_off; const char* cB = (const char*)g.Bt + (size_t)cur.pn * 2 * hB;
    PG8_STAGE(PG8_SB(0, 0), cB, voffB); PG8_STAGE(PG8_SB(0, 1), cB + hB, voffB); PG8_STAGE(PG8_SA(0, 0), cA, voffA); PG8_STAGE(PG8_SA(0, 1), cA + hA, voffA);
    if (wr == 1) PG8_BAR;
    PG8_WAIT_V(2); PG8_BAR;
    PG8_STAGE(PG8_SB(1, 0), cB + kstep, voffB); PG8_STAGE(PG8_SA(1, 0), cA + kstep, voffA); PG8_STAGE(PG8_SB(1, 1), cB + hB + kstep, voffB);
    PG8_WAIT_V(6); PG8_BAR;
    for (;;) {
        const bool has_next = S.next(ui + 1, nxt);
        const char* nA = has_next ? (const char*)g.A + (size_t)nxt.pm * 2 * hA + (size_t)nxt.pn * g.a_pn_off : cA; const char* nB = has_next ? (const char*)g.Bt + (size_t)nxt.pn * 2 * hB : cB;
        for (int t = 0; t < nt; t += 2) {
            const bool last = (t == nt - 2);
            const char* a1 = cA + (size_t)(t + 1) * kstep;
            const char* a2 = last ? nA : cA + (size_t)(t + 2) * kstep; const char* b2 = last ? nB : cB + (size_t)(t + 2) * kstep;
            const char* a3 = a2 + kstep; const char* b3 = b2 + kstep;
            PG8_LDB(B0, 0, 0); PG8_LDB(B1, 0, 1); PG8_SCHED; PG8_LDA(At, 0, 0); PG8_STAGE(PG8_SA(1, 1), a1 + hA, voffA);
            PG8_WAIT_V(8); PG8_WAIT_L(0); PG8_BAR; PG8_MMA(0, 0, At, B0); PG8_MMA(0, 1, At, B1); PG8_BAR; PG8_SCHED;
            PG8_LDA(At, 0, 1); PG8_STAGE(PG8_SB(0, 0), b2, voffB); PG8_STAGE(PG8_SB(0, 1), b2 + hB, voffB); PG8_STAGE(PG8_SA(0, 0), a2, voffA);
            PG8_WAIT_V(8); PG8_WAIT_L(0); PG8_BAR; PG8_MMA(1, 0, At, B0); PG8_MMA(1, 1, At, B1); PG8_BAR; PG8_SCHED;
            PG8_LDB(B0, 1, 0); PG8_LDB(B1, 1, 1); PG8_SCHED; PG8_LDA(At, 1, 0); PG8_STAGE(PG8_SA(0, 1), a2 + hA, voffA);
            PG8_WAIT_V(8); PG8_WAIT_L(0); PG8_BAR; PG8_MMA(0, 0, At, B0); PG8_MMA(0, 1, At, B1); PG8_BAR; PG8_SCHED;
            PG8_LDA(At, 1, 1); PG8_STAGE(PG8_SB(1, 0), b3, voffB); PG8_STAGE(PG8_SB(1, 1), b3 + hB, voffB); PG8_STAGE(PG8_SA(1, 0), a3, voffA);
            PG8_WAIT_V(8); PG8_WAIT_L(0); PG8_BAR; PG8_MMA(1, 0, At, B0); PG8_MMA(1, 1, At, B1); PG8_BAR; PG8_SCHED;
        }
        if (wr == 0) PG8_BAR;
        E(acc, cur, wr, wc, fr, fq);
        if (!has_next) break;
#pragma unroll
        for (int a = 0; a < 2; ++a)
#pragma unroll
            for (int b = 0; b < 2; ++b)
#pragma unroll
                for (int m = 0; m < 4; ++m)
#pragma unroll
                    for (int n = 0; n < 2; ++n) acc[a][b][m][n] = (f32x4){0.f, 0.f, 0.f, 0.f};
        cur = nxt; cA = nA; cB = nB; ++ui;
        if (wr == 1) PG8_BAR;
    }
    PG8_WAIT_V(0);
    PG8_BAR;
#undef PG8_SA
#undef PG8_SB
#undef PG8_STAGE
#undef PG8_LDA
#undef PG8_LDB
#undef PG8_MMA
#undef PG8_WAIT_V
#undef PG8_WAIT_L
#undef PG8_BAR
#undef PG8_SCHED
}

struct EpiInProj {
    static constexpr bool PERM = true;
    bf16_t* proj; float* ba;
    DI void operator()(const f32x4 (&acc)[2][2][4][2], const Unit& u, int wr, int wc, int fr, int fq) const {
        const int row0 = u.pm * BM + wr * 64 + fr;
        if (u.pn < 24) {
            const int col0 = u.pn * BM + wc * 32 + 8 * fq;
#pragma unroll
            for (int ai = 0; ai < 2; ++ai)
#pragma unroll
                for (int m = 0; m < 4; ++m) { bf16_t* rowp = proj + (size_t)(row0 + ai * HALF + m * 16) * NPROJ + col0;
#pragma unroll
                    for (int bj = 0; bj < 2; ++bj) { const f32x4 v0 = acc[ai][bj][m][0], v1 = acc[ai][bj][m][1];
                        u32x4 w; w.x = pk2(v0[0], v0[1]); w.y = pk2(v0[2], v0[3]); w.z = pk2(v1[0], v1[1]); w.w = pk2(v1[2], v1[3]);
                        *(u32x4*)(rowp + bj * HALF) = w; } }
        } else if (wc == 0) {
#pragma unroll
            for (int ai = 0; ai < 2; ++ai)
#pragma unroll
                for (int m = 0; m < 4; ++m) { float* rowp = ba + (size_t)(row0 + ai * HALF + m * 16) * 32 + 8 * fq;
                    *(f32x4*)(rowp) = acc[ai][0][m][0]; *(f32x4*)(rowp + 4) = acc[ai][0][m][1]; }
        }
    }
};
struct EpiRes {
    static constexpr bool PERM = false;
    const float* res_p; const float* res_s;
    const float* gate;
    const float* cscale; float* R;
    DI void operator()(const f32x4 (&acc)[2][2][4][2], const Unit& u, int wr, int wc, int fr, int fq) const {
        const int row0 = u.pm * BM + wr * 64 + fr, col0 = u.pn * BM + wc * 32 + 4 * fq;
        f32x4 cs[2][2];
#pragma unroll
        for (int bj = 0; bj < 2; ++bj)
#pragma unroll
            for (int n = 0; n < 2; ++n) cs[bj][n] = cscale ? *(const f32x4*)(cscale + col0 + bj * HALF + n * 16) : (f32x4){1.f, 1.f, 1.f, 1.f};
#pragma unroll
        for (int ai = 0; ai < 2; ++ai)
#pragma unroll
            for (int m = 0; m < 4; ++m) { const int row = row0 + ai * HALF + m * 16;
                if (row < TT) {
                    const float* rp = (row < TP ? res_p + (size_t)row * D : res_s + (size_t)(row - TP) * D) + col0;
                    const float* gp = gate + (size_t)batch_of(row) * 6144 + col0;
                    float* op = R + (size_t)row * D + col0;
#pragma unroll
                    for (int bj = 0; bj < 2; ++bj)
#pragma unroll
                        for (int n = 0; n < 2; ++n) { const f32x4 rv = *(const f32x4*)(rp + bj * HALF + n * 16), gv = *(const f32x4*)(gp + bj * HALF + n * 16);
                            *(f32x4*)(op + bj * HALF + n * 16) = rv * DN_ALPHA + gv * (acc[ai][bj][m][n] * cs[bj][n]); }
                } }
    }
};
struct EpiSwiGLU {
    static constexpr bool PERM = true;
    bf16_t* H;
    DI void operator()(const f32x4 (&acc)[2][2][4][2], const Unit& u, int wr, int wc, int fr, int fq) const {
        const int row0 = u.pm * BM + wr * 64 + fr, col0 = u.pn * HALF + wc * 32 + 8 * fq;
#pragma unroll
        for (int ai = 0; ai < 2; ++ai)
#pragma unroll
            for (int m = 0; m < 4; ++m) { float h[8];
#pragma unroll
                for (int n = 0; n < 2; ++n)
#pragma unroll
                    for (int j = 0; j < 4; ++j) h[n * 4 + j] = silu_f(acc[ai][0][m][n][j]) * acc[ai][1][m][n][j];
                *(u32x4*)(H + (size_t)(row0 + ai * HALF + m * 16) * DFF + col0) = pack8(h); }
    }
};
}

DI void transpose_tile(const float* __restrict__ src, int N, int k0, int n0, bf16_t* __restrict__ dst, int ldd, int drow0, LAS float* tile, int tid) {
#pragma unroll
    for (int i = 0; i < 2; ++i) { const int kr = (tid >> 4) + 32 * i, c4 = (tid & 15) * 4; f32x4 v = {0.f, 0.f, 0.f, 0.f};
        if (n0 + c4 < N) v = *(const f32x4*)(src + (size_t)(k0 + kr) * N + n0 + c4);
        LAS float* t = tile + kr * 65 + c4; t[0] = v[0]; t[1] = v[1]; t[2] = v[2]; t[3] = v[3]; }
    __syncthreads();
    const int n = tid >> 3, kc = (tid & 7) * 8; float f[8];
#pragma unroll
    for (int i = 0; i < 8; ++i) f[i] = tile[(kc + i) * 65 + n];
    *(u32x4*)(dst + (size_t)(drow0 + n) * ldd + k0 + kc) = pack8(f);
    __syncthreads();
}
DI void mod_item(const Params& p, int item, LAS unsigned char* lds, int tid) {
    const int l = item / 96, nb = item % 96, n0 = nb * 64;
    const int w = tid >> 6, lane = tid & 63, cgp = w & 1, ks = w >> 1, fr = lane & 15, fq = lane >> 4;
    const float* W = p.ada_w + (size_t)l * 1024 * 6144 + n0 + 32 * cgp + 2 * fr;
    f32x4 acc[9][2];
#pragma unroll
    for (int mb = 0; mb < 9; ++mb) { acc[mb][0] = (f32x4){0.f, 0.f, 0.f, 0.f}; acc[mb][1] = (f32x4){0.f, 0.f, 0.f, 0.f}; }
    for (int st = 0; st < 8; ++st) {
        const int k0 = ks * 256 + st * 32 + fq * 8;
        f32x2 wv[8];
#pragma unroll
        for (int i = 0; i < 8; ++i) wv[i] = *(const f32x2*)(W + (size_t)(k0 + i) * 6144);
        u32x4 t0, t1; t0.x = pk2(wv[0].x, wv[1].x); t0.y = pk2(wv[2].x, wv[3].x); t0.z = pk2(wv[4].x, wv[5].x); t0.w = pk2(wv[6].x, wv[7].x);
        t1.x = pk2(wv[0].y, wv[1].y); t1.y = pk2(wv[2].y, wv[3].y); t1.z = pk2(wv[4].y, wv[5].y); t1.w = pk2(wv[6].y, wv[7].y);
        const bf16x8 b0 = __builtin_bit_cast(bf16x8, t0), b1 = __builtin_bit_cast(bf16x8, t1);
#pragma unroll
        for (int mb = 0; mb < 9; ++mb) { const int row = 16 * mb + fr; u32x4 aw = {0u, 0u, 0u, 0u};
            if (row < NBC) { const float* cp = (row < 8 ? p.c_prompt + (size_t)row * D : p.c_sample + (size_t)(row - 8) * D) + k0;
                const f32x4 c0 = *(const f32x4*)cp, c1 = *(const f32x4*)(cp + 4);
                aw.x = pk2(silu_f(c0[0]), silu_f(c0[1])); aw.y = pk2(silu_f(c0[2]), silu_f(c0[3])); aw.z = pk2(silu_f(c1[0]), silu_f(c1[1])); aw.w = pk2(silu_f(c1[2]), silu_f(c1[3])); }
            const bf16x8 a = __builtin_bit_cast(bf16x8, aw);
            acc[mb][0] = MFMA16(a, b0, acc[mb][0]); acc[mb][1] = MFMA16(a, b1, acc[mb][1]); }
    }
    LAS f32x4* red = (LAS f32x4*)lds;
    if (ks > 0) {
#pragma unroll
        for (int mb = 0; mb < 9; ++mb)
#pragma unroll
            for (int e = 0; e < 2; ++e) red[((((ks - 1) * 2 + cgp) * 9 + mb) * 2 + e) * 64 + lane] = acc[mb][e];
    }
    __syncthreads();
    if (ks == 0) {
        float* mod = (float*)(p.ws + WS_MOD);
#pragma unroll
        for (int mb = 0; mb < 9; ++mb) {
#pragma unroll
            for (int e = 0; e < 2; ++e)
#pragma unroll
                for (int s = 0; s < 3; ++s) acc[mb][e] += red[(((s * 2 + cgp) * 9 + mb) * 2 + e) * 64 + lane];
            const int col = n0 + 32 * cgp + 2 * fr; const f32x2 bb = *(const f32x2*)(p.ada_b + (size_t)l * 6144 + col);
#pragma unroll
            for (int r = 0; r < 4; ++r) { const int row = 16 * mb + 4 * fq + r;
                if (row < NBC) { f32x2 o = {acc[mb][0][r] + bb.x, acc[mb][1][r] + bb.y}; *(f32x2*)(mod + ((size_t)(l * NBC + row)) * 6144 + col) = o; } }
        }
    }
    __syncthreads();
}
DI void phase0(const Params& p, LAS unsigned char* lds) {
    const int tid = threadIdx.x, G = gridDim.x, bx = blockIdx.x;
    for (int it = bx; it < 192; it += G) mod_item(p, it, lds, tid);
    LAS float* tile = (LAS float*)lds;
    for (int t = bx; t < 6352; t += G) {
        const float* src; int N, k0, n0, ldd, drow0; bf16_t* dst;
        if (t < 1552) { const int kt = t % 16, nt = t / 16; src = p.w_in; N = INDIM; k0 = 64 * kt; n0 = 64 * nt; dst = (bf16_t*)(p.ws + WS_WT_IN); ldd = 1024; drow0 = n0; }
        else if (t < 2064) { const int q = t - 1552, kt = q % 32, nt = q / 32; src = p.w_out; N = 1024; k0 = 64 * kt; n0 = 64 * nt; dst = (bf16_t*)(p.ws + WS_WT_OUT); ldd = 2048; drow0 = n0; }
        else if (t < 4880) { const int q = t - 2064, l = q / 1408, r = q % 1408, kt = r % 16, nt = r / 16; src = p.w_up + (size_t)l * 1024 * 5632; N = 5632; k0 = 64 * kt; n0 = 64 * nt;
            dst = (bf16_t*)(p.ws + WS_WT_UP) + (size_t)l * 5632 * 1024; ldd = 1024;
            drow0 = n0 < DFF ? 256 * (n0 / 128) + (n0 % 128) : 256 * ((n0 - DFF) / 128) + 128 + ((n0 - DFF) % 128); }
        else if (t < 6288) { const int q = t - 4880, l = q / 704, r = q % 704, kt = r % 44, nt = r / 44; src = p.w_down + (size_t)l * DFF * 1024; N = 1024; k0 = 64 * kt; n0 = 64 * nt;
            dst = (bf16_t*)(p.ws + WS_WT_DOWN) + (size_t)l * 1024 * DFF; ldd = DFF; drow0 = n0; }
        else { const int q = t - 6288, g = q / 16, r = q % 16, kt = r % 4, nt = r / 4; src = p.pool_w + (size_t)g * 65536; N = 256; k0 = 64 * kt; n0 = 64 * nt;
            dst = (bf16_t*)(p.ws + WS_WT_POOL) + (size_t)g * 65536; ldd = 256; drow0 = n0; }
        transpose_tile(src, N, k0, n0, dst, ldd, drow0, tile, tid);
    }
    { u32x4* z = (u32x4*)((bf16_t*)(p.ws + WS_WT_IN) + (size_t)6208 * 1024); const u32x4 zz = {0u, 0u, 0u, 0u};
      for (int i = bx * NTHR + tid; i < 192 * 1024 / 8; i += G * NTHR) z[i] = zz; }
}

DI void phase_u0(const Params& p) {
    const float* mod = (const float*)(p.ws + WS_MOD); bf16_t* U = (bf16_t*)(p.ws + WS_U);
    for (int i = blockIdx.x * NTHR + threadIdx.x; i < MP * 128; i += gridDim.x * NTHR) {
        const int row = i >> 7, c = (i & 127) * 8; float o[8];
        if (row < TT) { const float* xp = (row < TP ? p.x_prompt + (size_t)row * D : p.x_sample + (size_t)(row - TP) * D) + c; const float* mp = mod + (size_t)batch_of(row) * 6144 + c;
            const f32x4 x0 = *(const f32x4*)xp, x1 = *(const f32x4*)(xp + 4), h0 = *(const f32x4*)mp, h1 = *(const f32x4*)(mp + 4), s0 = *(const f32x4*)(mp + 1024), s1 = *(const f32x4*)(mp + 1028);
#pragma unroll
            for (int j = 0; j < 4; ++j) { o[j] = x0[j] * (1.f + s0[j]) + h0[j]; o[4 + j] = x1[j] * (1.f + s1[j]) + h1[j]; }
        } else {
#pragma unroll
            for (int j = 0; j < 8; ++j) o[j] = 0.f; }
        *(u32x4*)(U + (size_t)row * D + c) = pack8(o);
    }
}

template <int MODE>
DI void phase_ln(const Params& p, const float* g, const float* bb, const float* modsh  ) {
    const float* R = (const float*)(p.ws + WS_R); float* Y = p.out + O_Y; bf16_t* U = (bf16_t*)(p.ws + WS_U);
    const int lane = threadIdx.x & 63, w = threadIdx.x >> 6;
    for (int row = blockIdx.x * 8 + w; row < TT; row += gridDim.x * 8) {
        f32x4 x[4]; float s = 0.f;
#pragma unroll
        for (int i = 0; i < 4; ++i) { x[i] = *(const f32x4*)(R + (size_t)row * D + i * 256 + lane * 4); s += (x[i][0] + x[i][1]) + (x[i][2] + x[i][3]); }
#pragma unroll
        for (int o = 32; o >= 1; o >>= 1) s += __shfl_xor(s, o);
        const float mu = s * (1.f / 1024.f); float q = 0.f;
#pragma unroll
        for (int i = 0; i < 4; ++i) { x[i] = x[i] - mu; q += (x[i][0] * x[i][0] + x[i][1] * x[i][1]) + (x[i][2] * x[i][2] + x[i][3] * x[i][3]); }
#pragma unroll
        for (int o = 32; o >= 1; o >>= 1) q += __shfl_xor(q, o);
        const float rstd = rsqrtf(q * (1.f / 1024.f) + 1e-5f);
        const float* mp = MODE ? modsh + (size_t)batch_of(row) * 6144 : nullptr;
#pragma unroll
        for (int i = 0; i < 4; ++i) { const int c = i * 256 + lane * 4; const f32x4 gv = *(const f32x4*)(g + c), bv = *(const f32x4*)(bb + c);
            const f32x4 y = x[i] * rstd * gv + bv; *(f32x4*)(Y + (size_t)row * D + c) = y;
            if (MODE) { const f32x4 sh = *(const f32x4*)(mp + c), sc = *(const f32x4*)(mp + 1024 + c); const f32x4 u = y * (sc + 1.f) + sh;
                u32x2 wv; wv.x = pk2(u[0], u[1]); wv.y = pk2(u[2], u[3]); *(u32x2*)(U + (size_t)row * D + c) = wv; } }
    }
}

DI void phase_pool(const Params& p) {
    const float* Y = p.out + O_Y; const float* mod = (const float*)(p.ws + WS_MOD) + (size_t)NBC * 6144;
    bf16_t* U = (bf16_t*)(p.ws + WS_U);
    const int tid = threadIdx.x, c = tid * 2, gi = c >> 8, w = 2 << gi;
    for (int it = blockIdx.x; it < 256; it += gridDim.x) {
        const int b = it >> 5, t0 = (it & 31) * 64, rb = b * SEQ;
        const f32x2 sh = *(const f32x2*)(mod + (size_t)b * 6144 + c), sc = *(const f32x2*)(mod + (size_t)b * 6144 + 1024 + c);
        f32x2 sum = {0.f, 0.f};
        for (int j = 1; j < w; ++j) { const int t = t0 - j; if (t >= 0) { const f32x2 y = *(const f32x2*)(Y + (size_t)(rb + t) * D + c); sum += y * (sc + 1.f) + sh; } }
        for (int t = t0; t < t0 + 64; ++t) {
            const f32x2 y = *(const f32x2*)(Y + (size_t)(rb + t) * D + c); const f32x2 u = y * (sc + 1.f) + sh; sum += u;
            const float cnt = (float)(t + 1 < w ? t + 1 : w); const f32x2 pl = sum / cnt - u;
            *(unsigned*)(U + (size_t)(rb + t) * D + c) = pk2(pl.x, pl.y);
            if (t >= SEQ - 15) *(f32x2*)(p.out + O_PPOOL + ((size_t)b * 15 + (t - (SEQ - 15))) * D + c) = u;
            const int tl = t - w + 1; if (tl >= 0) { const f32x2 yl = *(const f32x2*)(Y + (size_t)(rb + tl) * D + c); sum -= yl * (sc + 1.f) + sh; }
        }
    }
    for (int sb = blockIdx.x; sb < TS; sb += gridDim.x) {
        const int b = 8 + sb, row = TP + sb;
        const f32x2 sh = *(const f32x2*)(mod + (size_t)b * 6144 + c), sc = *(const f32x2*)(mod + (size_t)b * 6144 + 1024 + c);
        const f32x2 y = *(const f32x2*)(Y + (size_t)row * D + c); const f32x2 u = y * (sc + 1.f) + sh; f32x2 sum = u;
        const float* pv = p.st_pool + (size_t)sb * 15 * D + c;
        for (int j = 1; j < w; ++j) sum += *(const f32x2*)(pv + (size_t)(15 - j) * D);
        const f32x2 pl = sum / (float)w - u; *(unsigned*)(U + (size_t)row * D + c) = pk2(pl.x, pl.y);
        float* so = p.out + O_SPOOL + (size_t)sb * 15 * D + c;
        for (int j = 0; j < 14; ++j) *(f32x2*)(so + (size_t)j * D) = *(const f32x2*)(pv + (size_t)(j + 1) * D);
        *(f32x2*)(so + (size_t)14 * D) = u;
    }
}

DI void prep_item(const Params& p, int item, LAS unsigned char* lds) {
    const int tid = threadIdx.x, lane = tid & 63, w = tid >> 6;
    const int b = item >> 8, hk = (item >> 5) & 7, n = item & 31, t0 = n * 64, R0 = b * SEQ + t0;
    const bf16_t* proj = (const bf16_t*)(p.ws + WS_PROJ); const float* ba = (const float*)(p.ws + WS_BA);
    LAS bf16_t* QL = (LAS bf16_t*)lds; LAS bf16_t* KL = (LAS bf16_t*)(lds + 17408); LAS bf16_t* KTL = (LAS bf16_t*)(lds + 34816); LAS bf16_t* VTL = (LAS bf16_t*)(lds + 53248);
    LAS float* NL = (LAS float*)(lds + 90112); LAS float* GCL = (LAS float*)(lds + 122880); LAS float* BL = (LAS float*)(lds + 123392); LAS float* SCL = (LAS float*)(lds + 123904);
    {
        const int tg = w, cgi = lane;
        const int cls = cgi < 16 ? 0 : (cgi < 32 ? 1 : 2);
        const int col = cls == 0 ? hk * 128 + cgi * 8 : (cls == 1 ? 1024 + hk * 128 + (cgi - 16) * 8 : 2048 + hk * 256 + (cgi - 32) * 8);
        float y[8][8];
#pragma unroll
        for (int tt = 0; tt < 8; ++tt)
#pragma unroll
            for (int cc = 0; cc < 8; ++cc) y[tt][cc] = 0.f;
        float wj[4][8];
#pragma unroll
        for (int j = 0; j < 4; ++j) { const f32x4 a = *(const f32x4*)(p.conv_w + (size_t)j * CONVD + col), c2 = *(const f32x4*)(p.conv_w + (size_t)j * CONVD + col + 4);
#pragma unroll
            for (int cc = 0; cc < 4; ++cc) { wj[j][cc] = a[cc]; wj[j][4 + cc] = c2[cc]; } }
#pragma unroll
        for (int i = 0; i < 11; ++i) {
            const int t = t0 + 8 * tg - 3 + i; float x[8];
            if (t >= 0) { const u32x4 v = *(const u32x4*)(proj + (size_t)(b * SEQ + t) * NPROJ + col); unpack8(v, x); }
            else {
#pragma unroll
                for (int cc = 0; cc < 8; ++cc) x[cc] = 0.f; }
#pragma unroll
            for (int j = 0; j < 4; ++j) { const int tt = i - j; if (tt >= 0 && tt < 8) {
#pragma unroll
                    for (int cc = 0; cc < 8; ++cc) y[tt][cc] += wj[j][cc] * x[cc]; } }
        }
#pragma unroll
        for (int tt = 0; tt < 8; ++tt) { float ss = 0.f;
#pragma unroll
            for (int cc = 0; cc < 8; ++cc) { y[tt][cc] = silu_f(y[tt][cc]); ss += y[tt][cc] * y[tt][cc]; }
            ss += __shfl_xor(ss, 1); ss += __shfl_xor(ss, 2); ss += __shfl_xor(ss, 4); ss += __shfl_xor(ss, 8);
            if (cls < 2) { const float sc = rsqrtf(ss + 1e-6f) * (cls == 0 ? 0.08838834764831845f : 1.f);
#pragma unroll
                for (int cc = 0; cc < 8; ++cc) y[tt][cc] *= sc; } }
        if (cls == 0) { bf16_t* Qg = (bf16_t*)(p.ws + WS_Q) + ((size_t)(b * 8 + hk) * SEQ + t0 + 8 * tg) * 128 + cgi * 8;
#pragma unroll
            for (int tt = 0; tt < 8; ++tt) { const u32x4 v = pack8(y[tt]); *(LAS u32x4*)(QL + (8 * tg + tt) * 136 + cgi * 8) = v; *(u32x4*)(Qg + (size_t)tt * 128) = v; } }
        else {
            if (cls == 1) {
#pragma unroll
                for (int tt = 0; tt < 8; ++tt) *(LAS u32x4*)(KL + (8 * tg + tt) * 136 + (cgi - 16) * 8) = pack8(y[tt]); }
            LAS bf16_t* TL = cls == 1 ? KTL + (cgi - 16) * 8 * 72 : VTL + (cgi - 32) * 8 * 72;
            bf16_t* KTg = (bf16_t*)(p.ws + WS_KT) + ((size_t)((b * 8 + hk) * 32 + n) * 128 + (cgi - 16) * 8) * 64 + 8 * tg;
#pragma unroll
            for (int cc = 0; cc < 8; ++cc) { float tcol[8];
#pragma unroll
                for (int tt = 0; tt < 8; ++tt) tcol[tt] = y[tt][cc];
                const u32x4 v = pack8(tcol); *(LAS u32x4*)(TL + cc * 72 + 8 * tg) = v;
                if (cls == 1) *(u32x4*)(KTg + (size_t)cc * 64) = v; }
        }
        if (w < 2) { const int e = w, h = 2 * hk + e, row = R0 + lane;
            const float bv = ba[(size_t)row * 32 + h], av = ba[(size_t)row * 32 + 16 + h];
            const float beta = sigmoid_f(bv); float g = -__expf(p.A_log[h]) * softplus_f(av + p.dt_bias[h]);
#pragma unroll
            for (int o = 1; o < 64; o <<= 1) { const float t = __shfl_up(g, o); if (lane >= o) g += t; }
            GCL[e * 64 + lane] = g; BL[e * 64 + lane] = beta; SCL[(e * 2 + 0) * 64 + lane] = beta; SCL[(e * 2 + 1) * 64 + lane] = beta * __expf(g);
            ((float*)(p.ws + WS_GC))[(size_t)(b * 16 + h) * SEQ + t0 + lane] = g; }
    }
    __syncthreads();
    {
        const int fr = lane & 15, fq = lane >> 4;
        for (int q = w; q < 32; q += 8) {
            const int type = q >> 4, jt = (q >> 2) & 3, it = q & 3;
            f32x4 c = {0.f, 0.f, 0.f, 0.f};
            if (it >= jt) { const LAS bf16_t* XL = type ? QL : KL;
#pragma unroll
                for (int ks = 0; ks < 4; ++ks) { const bf16x8 a = *(const LAS bf16x8*)(KL + (16 * jt + fr) * 136 + 32 * ks + fq * 8), bb = *(const LAS bf16x8*)(XL + (16 * it + fr) * 136 + 32 * ks + fq * 8);
                    c = MFMA16(a, bb, c); } }
            const int i = 16 * it + fr, j0 = 16 * jt + 4 * fq;
#pragma unroll
            for (int e = 0; e < 2; ++e) { const float gi = GCL[e * 64 + i], bi = BL[e * 64 + i]; f32x4 o;
#pragma unroll
                for (int r = 0; r < 4; ++r) { const int j = j0 + r; const float dec = __expf(gi - GCL[e * 64 + j]);
                    o[r] = type ? (i >= j ? c[r] * dec : 0.f) : (i > j ? bi * c[r] * dec : 0.f); }
                if (type == 0) *(LAS f32x4*)(NL + (e * 64 + i) * 64 + j0) = o;
                else { bf16_t* at = (bf16_t*)(p.ws + WS_U) + ((size_t)((b * 16 + 2 * hk + e) * 32 + n) * 64 + i) * 64 + j0; u32x2 wv; wv.x = pk2(o[0], o[1]); wv.y = pk2(o[2], o[3]); *(u32x2*)at = wv; } }
        }
    }
    __syncthreads();
    {
        const int e = w >> 2, part = w & 3, h = 2 * hk + e;
        const LAS bf16_t* src = part < 2 ? VTL + (e * 128 + part * 64 + lane) * 72 : KTL + ((part - 2) * 64 + lane) * 72;
        const LAS float* sc = SCL + (e * 2 + (part >> 1)) * 64; const LAS float* Ne = NL + e * 4096;
        float X[64];
#pragma unroll
        for (int k = 0; k < 8; ++k) { const u32x4 v = *(const LAS u32x4*)(src + 8 * k); float f[8]; unpack8(v, f); const f32x4 s0 = *(const LAS f32x4*)(sc + 8 * k), s1 = *(const LAS f32x4*)(sc + 8 * k + 4);
#pragma unroll
            for (int j = 0; j < 4; ++j) { X[8 * k + j] = f[j] * s0[j]; X[8 * k + 4 + j] = f[4 + j] * s1[j]; } }
#pragma unroll
        for (int i = 1; i < 64; ++i) { float a0 = 0.f, a1 = 0.f;
#pragma unroll
            for (int j4 = 0; j4 < (i + 3) / 4; ++j4) { const f32x4 nv = *(const LAS f32x4*)(Ne + i * 64 + 4 * j4);
#pragma unroll
                for (int r = 0; r < 4; ++r) if (4 * j4 + r < i) { if (r & 1) a1 += nv[r] * X[4 * j4 + r]; else a0 += nv[r] * X[4 * j4 + r]; } }
            X[i] -= a0 + a1; }
        if (part < 2) { bf16_t* vt = (bf16_t*)(p.ws + WS_VALT) + ((size_t)((b * 16 + h) * 32 + n) * 128 + part * 64 + lane) * 64;
#pragma unroll
            for (int k = 0; k < 8; ++k) *(u32x4*)(vt + 8 * k) = pack8(X + 8 * k); }
        else { bf16_t* kc = (bf16_t*)(p.ws + WS_KCUM) + ((size_t)(b * 16 + h) * SEQ + t0) * 128 + (part - 2) * 64 + lane;
#pragma unroll
            for (int i = 0; i < 64; ++i) kc[(size_t)i * 128] = (bf16_t)(pk2(X[i], 0.f) & 0xffffu); }
    }
    __syncthreads();
}
DI void phase_prep(const Params& p, LAS unsigned char* lds) {
    for (int it = blockIdx.x; it < 2048; it += gridDim.x) prep_item(p, it, lds);
    const bf16_t* proj = (const bf16_t*)(p.ws + WS_PROJ);
    for (int i = blockIdx.x * NTHR + threadIdx.x; i < 8 * 3 * 512; i += gridDim.x * NTHR) { const int c = (i & 511) * 8, bj = i >> 9, b = bj / 3, j = bj % 3;
        const u32x4 v = *(const u32x4*)(proj + (size_t)(b * SEQ + SEQ - 3 + j) * NPROJ + c); float f[8]; unpack8(v, f);
        float* o = p.out + O_PCONV + (size_t)bj * CONVD + c; *(f32x4*)o = (f32x4){f[0], f[1], f[2], f[3]}; *(f32x4*)(o + 4) = (f32x4){f[4], f[5], f[6], f[7]}; }
}

DI bf16x8 ld2x4(const bf16_t* p0) { const u32x2 a = *(const u32x2*)p0, b = *(const u32x2*)(p0 + 16); u32x4 w = {a.x, a.y, b.x, b.y}; return __builtin_bit_cast(bf16x8, w); }
DI bf16x8 packB(const f32x4& lo, const f32x4& hi) { u32x4 w = {pk2(lo[0], lo[1]), pk2(lo[2], lo[3]), pk2(hi[0], hi[1]), pk2(hi[2], hi[3])}; return __builtin_bit_cast(bf16x8, w); }
DI void scan_bh(const Params& p, int bh) {
    const int tid = threadIdx.x, lane = tid & 63, w = tid >> 6, fr = lane & 15, fq = lane >> 4;
    const int b = bh >> 4, h = bh & 15, hk = h >> 1;
    bf16_t* OG = (bf16_t*)(p.out);
    float* SSQ = (float*)(p.ws + WS_SSQ);
    if (w < 4) {
        const int dv0 = 32 * w;
        f32x4 S[8][2];
#pragma unroll
        for (int kb = 0; kb < 8; ++kb) { S[kb][0] = (f32x4){0.f, 0.f, 0.f, 0.f}; S[kb][1] = (f32x4){0.f, 0.f, 0.f, 0.f}; }
        for (int n = 0; n < 32; ++n) {
            const bf16_t* KC = (const bf16_t*)(p.ws + WS_KCUM) + ((size_t)bh * SEQ + n * 64) * 128;
            const bf16_t* QQ = (const bf16_t*)(p.ws + WS_Q) + ((size_t)(b * 8 + hk) * SEQ + n * 64) * 128;
            const bf16_t* AT = (const bf16_t*)(p.ws + WS_U) + (size_t)(bh * 32 + n) * 4096;
            const bf16_t* KTp = (const bf16_t*)(p.ws + WS_KT) + (size_t)((b * 8 + hk) * 32 + n) * 8192;
            const bf16_t* VT = (const bf16_t*)(p.ws + WS_VALT) + (size_t)(bh * 32 + n) * 8192;
            const float* gcp = (const float*)(p.ws + WS_GC) + (size_t)bh * SEQ + n * 64;
            const float gl = gcp[63], egl = __expf(gl);
            bf16x8 Sb[4][2];
#pragma unroll
            for (int ks = 0; ks < 4; ++ks) { Sb[ks][0] = packB(S[2 * ks][0], S[2 * ks + 1][0]); Sb[ks][1] = packB(S[2 * ks][1], S[2 * ks + 1][1]); }
            u32x2 vb[4][2], vs[4][2];
#pragma unroll
            for (int mt = 0; mt < 4; ++mt) {
                f32x4 pa = {0.f, 0.f, 0.f, 0.f}, pb = pa, qa = pa, qb = pa;
#pragma unroll
                for (int ks = 0; ks < 4; ++ks) { const bf16x8 ak = ld2x4(KC + (size_t)(16 * mt + fr) * 128 + 32 * ks + 4 * fq), aq = ld2x4(QQ + (size_t)(16 * mt + fr) * 128 + 32 * ks + 4 * fq);
                    pa = MFMA16(ak, Sb[ks][0], pa); pb = MFMA16(ak, Sb[ks][1], pb); qa = MFMA16(aq, Sb[ks][0], qa); qb = MFMA16(aq, Sb[ks][1], qb); }
                const u32x2 v0 = *(const u32x2*)(VT + (size_t)(dv0 + fr) * 64 + 16 * mt + 4 * fq), v1 = *(const u32x2*)(VT + (size_t)(dv0 + 16 + fr) * 64 + 16 * mt + 4 * fq);
                const f32x4 vn0 = (f32x4){bflo(v0.x), bfhi(v0.x), bflo(v0.y), bfhi(v0.y)} - pa, vn1 = (f32x4){bflo(v1.x), bfhi(v1.x), bflo(v1.y), bfhi(v1.y)} - pb;
                const f32x4 gcr = *(const f32x4*)(gcp + 16 * mt + 4 * fq);
                f32x4 eg, dd;
#pragma unroll
                for (int r = 0; r < 4; ++r) { eg[r] = __expf(gcr[r]); dd[r] = __expf(gl - gcr[r]); }
                vb[mt][0] = (u32x2){pk2(vn0[0], vn0[1]), pk2(vn0[2], vn0[3])}; vb[mt][1] = (u32x2){pk2(vn1[0], vn1[1]), pk2(vn1[2], vn1[3])};
                { const f32x4 s0 = vn0 * dd, s1 = vn1 * dd; vs[mt][0] = (u32x2){pk2(s0[0], s0[1]), pk2(s0[2], s0[3])}; vs[mt][1] = (u32x2){pk2(s1[0], s1[1]), pk2(s1[2], s1[3])}; }
                f32x4 o0 = qa * eg, o1 = qb * eg;
#pragma unroll
                for (int kk = 0; kk < 2; ++kk) if (2 * kk <= mt) { const bf16x8 aa = ld2x4(AT + (size_t)(16 * mt + fr) * 64 + 32 * kk + 4 * fq);
                    const u32x2 z2 = {0u, 0u}; const u32x2 h0 = (2 * kk + 1 <= mt) ? vb[2 * kk + 1][0] : z2, h1 = (2 * kk + 1 <= mt) ? vb[2 * kk + 1][1] : z2;
                    const u32x4 w0 = {vb[2 * kk][0].x, vb[2 * kk][0].y, h0.x, h0.y}, w1 = {vb[2 * kk][1].x, vb[2 * kk][1].y, h1.x, h1.y};
                    o0 = MFMA16(aa, __builtin_bit_cast(bf16x8, w0), o0); o1 = MFMA16(aa, __builtin_bit_cast(bf16x8, w1), o1); }
                f32x4 sq = o0 * o0 + o1 * o1;
#pragma unroll
                for (int r = 0; r < 4; ++r) { float sx = sq[r]; sx += __shfl_xor(sx, 1); sx += __shfl_xor(sx, 2); sx += __shfl_xor(sx, 4); sx += __shfl_xor(sx, 8); sq[r] = sx; }
#pragma unroll
                for (int r = 0; r < 4; ++r) { const size_t row = (size_t)b * SEQ + n * 64 + 16 * mt + 4 * fq + r; bf16_t* op = OG + row * 2048 + h * 128 + dv0 + fr;
                    op[0] = (bf16_t)(pk2(o0[r], 0.f) & 0xffffu); op[16] = (bf16_t)(pk2(o1[r], 0.f) & 0xffffu);
                    if (fr == 0) SSQ[(row * 16 + h) * 4 + w] = sq[r]; }
            }
            bf16x8 Vs[2][2];
#pragma unroll
            for (int kk = 0; kk < 2; ++kk)
#pragma unroll
                for (int ct = 0; ct < 2; ++ct) { const u32x4 wv = {vs[2 * kk][ct].x, vs[2 * kk][ct].y, vs[2 * kk + 1][ct].x, vs[2 * kk + 1][ct].y}; Vs[kk][ct] = __builtin_bit_cast(bf16x8, wv); }
#pragma unroll
            for (int kb = 0; kb < 8; ++kb) { S[kb][0] *= egl; S[kb][1] *= egl;
#pragma unroll
                for (int kk = 0; kk < 2; ++kk) { const bf16x8 aa = ld2x4(KTp + (size_t)(16 * kb + fr) * 64 + 32 * kk + 4 * fq);
                    S[kb][0] = MFMA16(aa, Vs[kk][0], S[kb][0]); S[kb][1] = MFMA16(aa, Vs[kk][1], S[kb][1]); } }
        }
        float* ps = p.out + O_PS + (size_t)bh * 16384;
#pragma unroll
        for (int kb = 0; kb < 8; ++kb)
#pragma unroll
            for (int r = 0; r < 4; ++r) { ps[(size_t)(16 * kb + 4 * fq + r) * 128 + dv0 + fr] = S[kb][0][r]; ps[(size_t)(16 * kb + 4 * fq + r) * 128 + dv0 + 16 + fr] = S[kb][1][r]; }
    }
    __threadfence();
    __syncthreads();
    const bf16_t* proj = (const bf16_t*)(p.ws + WS_PROJ);
    for (int idx = tid; idx < SEQ * 16; idx += NTHR) { const int t = idx >> 4, c8 = (idx & 15) * 8; const size_t row = (size_t)b * SEQ + t;
        bf16_t* op = OG + row * 2048 + h * 128 + c8; float o[8], z[8]; unpack8(*(const u32x4*)op, o); unpack8(*(const u32x4*)(proj + row * NPROJ + 4096 + h * 128 + c8), z);
        const f32x4 sp = *(const f32x4*)(SSQ + (row * 16 + h) * 4); const float rs = rsqrtf(((sp[0] + sp[1]) + (sp[2] + sp[3])) * (1.f / 128.f) + 1e-6f);
        const f32x4 n0 = *(const f32x4*)(p.norm_w + c8), n1 = *(const f32x4*)(p.norm_w + c8 + 4);
#pragma unroll
        for (int j = 0; j < 8; ++j) o[j] = o[j] * rs * (j < 4 ? n0[j] : n1[j - 4]) * silu_f(z[j]);
        *(u32x4*)op = pack8(o); }
}
DI void sample_item(const Params& p, int item, LAS float* sm, int gt  ) {
    const int sb = item >> 4, h = item & 15, hk = h >> 1, row = TP + sb;
    const bf16_t* proj = (const bf16_t*)(p.ws + WS_PROJ) + (size_t)row * NPROJ; const float* ba = (const float*)(p.ws + WS_BA) + (size_t)row * 32;
    const float* cs = p.st_conv + (size_t)sb * 3 * CONVD;
    LAS float* qv = sm; LAS float* kv = sm + 128; LAS float* vv = sm + 256; LAS float* red = sm + 384;
    LAS float* part = sm + 400;
    {
        const int c = gt < 128 ? hk * 128 + gt : 1024 + hk * 128 + (gt - 128);
        const float cur = bflo((unsigned)proj[c]); const float x0 = cs[c], x1 = cs[CONVD + c], x2 = cs[2 * CONVD + c];
        const float y = silu_f(p.conv_w[c] * x0 + p.conv_w[CONVD + c] * x1 + p.conv_w[2 * CONVD + c] * x2 + p.conv_w[3 * CONVD + c] * cur);
        sm[gt] = y;
        if ((h & 1) == 0) { float* so = p.out + O_SCONV + (size_t)sb * 3 * CONVD + c; so[0] = x1; so[CONVD] = x2; so[2 * CONVD] = cur; }
        if (gt < 128) { const int cv = 2048 + h * 128 + gt; const float cu = bflo((unsigned)proj[cv]); const float a0 = cs[cv], a1 = cs[CONVD + cv], a2 = cs[2 * CONVD + cv];
            vv[gt] = silu_f(p.conv_w[cv] * a0 + p.conv_w[CONVD + cv] * a1 + p.conv_w[2 * CONVD + cv] * a2 + p.conv_w[3 * CONVD + cv] * cu);
            float* so = p.out + O_SCONV + (size_t)sb * 3 * CONVD + cv; so[0] = a1; so[CONVD] = a2; so[2 * CONVD] = cu; }
    }
    __syncthreads();
    {
        const int gw = gt >> 6, l = gt & 63;
        if (gw < 3) { const float a0 = gw == 1 ? kv[l] : qv[l], a1 = gw == 1 ? kv[64 + l] : qv[64 + l], b0 = gw == 0 ? qv[l] : kv[l], b1 = gw == 0 ? qv[64 + l] : kv[64 + l];
            float s = a0 * b0 + a1 * b1;
#pragma unroll
            for (int o = 32; o >= 1; o >>= 1) s += __shfl_xor(s, o);
            if (l == 0) red[gw] = s; }
    }
    __syncthreads();
    const float qs = rsqrtf(red[0] + 1e-6f) * 0.08838834764831845f, ksc = rsqrtf(red[1] + 1e-6f), qk = red[2] * qs * ksc;
    const float beta = sigmoid_f(ba[h]), g = -__expf(p.A_log[h]) * softplus_f(ba[16 + h] + p.dt_bias[h]), eg = __expf(g);
    const int rg = gt >> 5, c4 = (gt & 31) * 4;
    const float* S0 = p.st_S + ((size_t)(sb * 16 + h) * 128 + rg * 16) * 128 + c4;
    f32x4 Sr[16]; f32x4 ks4 = {0.f, 0.f, 0.f, 0.f}, qs4 = ks4;
#pragma unroll
    for (int r = 0; r < 16; ++r) { Sr[r] = *(const f32x4*)(S0 + (size_t)r * 128); const float kr = kv[rg * 16 + r], qr = qv[rg * 16 + r]; ks4 += Sr[r] * kr; qs4 += Sr[r] * qr; }
    *(LAS f32x4*)(part + rg * 128 + c4) = ks4; *(LAS f32x4*)(part + 1024 + rg * 128 + c4) = qs4;
    __syncthreads();
    f32x4 kS = {0.f, 0.f, 0.f, 0.f}, qS = kS;
#pragma unroll
    for (int r = 0; r < 8; ++r) { kS += *(const LAS f32x4*)(part + r * 128 + c4); qS += *(const LAS f32x4*)(part + 1024 + r * 128 + c4); }
    kS *= ksc; qS *= qs;
    const f32x4 v4 = *(const LAS f32x4*)(vv + c4);
    const f32x4 vnew = (v4 - kS * eg) * beta;
    const f32x4 o4 = qS * eg + vnew * qk;
    float* S1 = p.out + O_SS + ((size_t)(sb * 16 + h) * 128 + rg * 16) * 128 + c4;
#pragma unroll
    for (int r = 0; r < 16; ++r) { const float kr = kv[rg * 16 + r] * ksc; *(f32x4*)(S1 + (size_t)r * 128) = Sr[r] * eg + vnew * kr; }
    if (rg == 0) {
        float s = (o4[0] * o4[0] + o4[1] * o4[1]) + (o4[2] * o4[2] + o4[3] * o4[3]);
#pragma unroll
        for (int o = 16; o >= 1; o >>= 1) s += __shfl_xor(s, o);
        const float rs = rsqrtf(s * (1.f / 128.f) + 1e-6f);
        const u32x2 zz = *(const u32x2*)(proj + 4096 + h * 128 + c4); const float z[4] = {bflo(zz.x), bfhi(zz.x), bflo(zz.y), bfhi(zz.y)};
        const f32x4 nw = *(const f32x4*)(p.norm_w + c4); float og[4];
#pragma unroll
        for (int j = 0; j < 4; ++j) og[j] = o4[j] * rs * nw[j] * silu_f(z[j]);
        u32x2 wv; wv.x = pk2(og[0], og[1]); wv.y = pk2(og[2], og[3]);
        *(u32x2*)((bf16_t*)p.out + (size_t)row * 2048 + h * 128 + c4) = wv;
    }
    __syncthreads();
}
DI void phase_scan(const Params& p, LAS unsigned char* lds) {
    const int G = gridDim.x, bx = blockIdx.x;
    const int half = G / 2 > 0 ? G / 2 : 1;
    if (bx < half) { for (int bh = bx; bh < 128; bh += half) { scan_bh(p, bh); __syncthreads(); } }
    if (bx >= half || G == 1) {
        const int nb = G == 1 ? 1 : G - half, me = G == 1 ? 0 : bx - half; const int grp = threadIdx.x >> 8, gt = threadIdx.x & 255;
        LAS float* sm = (LAS float*)lds + grp * 4096;
        for (int it = me * 2 + grp; it < 2048; it += nb * 2) sample_item(p, it, sm, gt);
    }
}

__global__ void __launch_bounds__(NTHR) mk_fwd(Params p_arg) {
    const Params& p = *(const Params*)__builtin_amdgcn_kernarg_segment_ptr();
    extern __shared__ __attribute__((aligned(16))) unsigned char lds_raw[];
    LAS unsigned char* lds = (LAS unsigned char*)lds_raw;
    cg::grid_group grid = cg::this_grid();
    const int G = gridDim.x, bx = blockIdx.x;
    const float* mod = (const float*)(p.ws + WS_MOD);
    bf16_t* U = (bf16_t*)(p.ws + WS_U); bf16_t* PROJ = (bf16_t*)(p.ws + WS_PROJ); bf16_t* H = PROJ; float* R = (float*)(p.ws + WS_R);
    const float* Y = p.out + O_Y;
#define SEAM(k) do { if ((k) + 1 < p.ph_hi) grid.sync(); } while (0)
#define IN(k) (p.ph_lo <= (k) && (k) < p.ph_hi)
    if (IN(0)) { phase0(p, lds); SEAM(0); }
    if (IN(1)) { phase_u0(p); SEAM(1); }
    if (IN(2)) { pg8::Gemm g{U, (const bf16_t*)(p.ws + WS_WT_IN), 1024, 1024, 1024, 0}; pg8::StaticOrder S; S.init(MP, INPAD, G, bx);
        pg8::EpiInProj E{PROJ, (float*)(p.ws + WS_BA)}; pg8::gemm_phase(lds, g, S, E); SEAM(2); }
    if (IN(3)) { phase_prep(p, lds); SEAM(3); }
    if (IN(4)) { phase_scan(p, lds); SEAM(4); }
    if (IN(5)) { pg8::Gemm g{(const bf16_t*)p.out, (const bf16_t*)(p.ws + WS_WT_OUT), 2048, 2048, 2048, 0}; pg8::StaticOrder S; S.init(MP, 1024, G, bx);
        pg8::EpiRes E{p.x_prompt, p.x_sample, mod + 2048, nullptr, R}; pg8::gemm_phase(lds, g, S, E); SEAM(5); }
    if (IN(6)) { phase_ln<1>(p, p.ln_g, p.ln_b, mod + 3072); SEAM(6); }
#pragma unroll
    for (int l = 0; l < 2; ++l) {
        const int pb = l == 0 ? 7 : 13;
        if (IN(pb)) { pg8::Gemm g{U, (const bf16_t*)(p.ws + WS_WT_UP) + (size_t)l * 5632 * 1024, 1024, 1024, 1024, 0}; pg8::StaticOrder S; S.init(MP, 5632, G, bx);
            pg8::EpiSwiGLU E{H}; pg8::gemm_phase(lds, g, S, E); SEAM(pb); }
        if (IN(pb + 1)) { pg8::Gemm g{H, (const bf16_t*)(p.ws + WS_WT_DOWN) + (size_t)l * 1024 * DFF, DFF, DFF, DFF, 0}; pg8::StaticOrder S; S.init(MP, 1024, G, bx);
            pg8::EpiRes E{Y, Y + (size_t)TP * D, mod + (size_t)l * NBC * 6144 + 5120, nullptr, R}; pg8::gemm_phase(lds, g, S, E); SEAM(pb + 1); }
        if (l == 0) {
            if (IN(9)) { phase_ln<0>(p, p.ln_g + 1024, p.ln_b + 1024, nullptr); SEAM(9); }
            if (IN(10)) { phase_pool(p); SEAM(10); }
            if (IN(11)) { pg8::Gemm g{U, (const bf16_t*)(p.ws + WS_WT_POOL), 1024, 256, 256, 512}; pg8::StaticOrder S; S.init(MP, 1024, G, bx);
                pg8::EpiRes E{Y, Y + (size_t)TP * D, mod + (size_t)NBC * 6144 + 2048, p.pool_scale, R}; pg8::gemm_phase(lds, g, S, E); SEAM(11); }
            if (IN(12)) { phase_ln<1>(p, p.ln_g + 2048, p.ln_b + 2048, mod + (size_t)NBC * 6144 + 3072); SEAM(12); }
        } else {
            if (IN(15)) { phase_ln<0>(p, p.ln_g + 3072, p.ln_b + 3072, nullptr); }
        }
    }
#undef SEAM
#undef IN
}

extern "C" void kernel_launch(void* const* d_in, const int* in_sizes, int n_in, void* d_out, int out_size, void* d_ws, size_t ws_size, hipStream_t stream) {
    static int grid = 0;
    if (grid == 0) {
        if (ws_size < WS_END) { fprintf(stderr, "kernel_launch: workspace too small: %zu < %zu\n", ws_size, (size_t)WS_END); grid = -1; return; }
        int dev = 0, cus = 0, per_cu = 0;
        hipGetDevice(&dev); hipDeviceGetAttribute(&cus, hipDeviceAttributeMultiprocessorCount, dev);
        if (hipFuncSetAttribute((const void*)mk_fwd, hipFuncAttributeMaxDynamicSharedMemorySize, LDS_BYTES) != hipSuccess) { fprintf(stderr, "kernel_launch: hipFuncSetAttribute failed\n"); grid = -1; return; }
        if (hipOccupancyMaxActiveBlocksPerMultiprocessor(&per_cu, (const void*)mk_fwd, NTHR, LDS_BYTES) != hipSuccess || per_cu < 1) { fprintf(stderr, "kernel_launch: occupancy query failed (%d)\n", per_cu); (void)hipGetLastError(); per_cu = 1; }
        grid = cus;
        fprintf(stderr, "kernel_launch: cus %d per_cu %d grid %d ws %zu\n", cus, per_cu, grid, ws_size);
    }
    if (grid < 0) return;
    Params p{};
    p.x_prompt = (const float*)d_in[0]; p.x_sample = (const float*)d_in[1]; p.c_prompt = (const float*)d_in[2]; p.c_sample = (const float*)d_in[3];
    p.st_S = (const float*)d_in[4]; p.st_conv = (const float*)d_in[5]; p.st_pool = (const float*)d_in[6]; p.ada_w = (const float*)d_in[7]; p.ada_b = (const float*)d_in[8];
    p.ln_g = (const float*)d_in[9]; p.ln_b = (const float*)d_in[10]; p.w_in = (const float*)d_in[11]; p.conv_w = (const float*)d_in[12]; p.A_log = (const float*)d_in[13];
    p.dt_bias = (const float*)d_in[14]; p.norm_w = (const float*)d_in[15]; p.w_out = (const float*)d_in[16]; p.pool_w = (const float*)d_in[17]; p.pool_scale = (const float*)d_in[18];
    p.w_up = (const float*)d_in[19]; p.w_down = (const float*)d_in[20];
    p.out = (float*)d_out; p.ws = (unsigned char*)d_ws; p.ph_lo = 0; p.ph_hi = 16;
    void* args[] = {&p};
    hipError_t e = hipLaunchCooperativeKernel((const void*)mk_fwd, dim3(grid), dim3(NTHR), args, LDS_BYTES, stream);
    if (e != hipSuccess) fprintf(stderr, "kernel_launch: cooperative launch failed: %s (grid %d)\n", hipGetErrorString(e), grid);
}
```

```cpp
#include <hip/hip_runtime.h>
#include <hip/hip_cooperative_groups.h>
#include <cstdio>
namespace cg = cooperative_groups;

#define LAS __attribute__((address_space(3)))
#define DI __device__ __forceinline__
typedef unsigned short bf16_t;
typedef short bf16x8 __attribute__((ext_vector_type(8)));
typedef float f32x4 __attribute__((ext_vector_type(4)));
typedef float f32x2 __attribute__((ext_vector_type(2)));
typedef unsigned u32x4 __attribute__((ext_vector_type(4)));
typedef unsigned u32x2 __attribute__((ext_vector_type(2)));
typedef __bf16 bf2_t __attribute__((ext_vector_type(2)));

constexpr int D = 1024, TP = 16384, TS = 128, TT = TP + TS, MP = 16640, NBC = 136, SEQ = 2048;
constexpr int NPROJ = 6144, INPAD = 6400, INDIM = 6176, DFF = 2816, CONVD = 4096;
constexpr float DN_ALPHA = 1.4142135623730951f;
constexpr int NTHR = 512;
constexpr int LDS_BYTES = 163840;

constexpr size_t WS_WT_IN = 0;
constexpr size_t WS_WT_OUT = WS_WT_IN + (size_t)INPAD * 1024 * 2;
constexpr size_t WS_WT_UP = WS_WT_OUT + (size_t)1024 * 2048 * 2;
constexpr size_t WS_WT_DOWN = WS_WT_UP + (size_t)2 * 5632 * 1024 * 2;
constexpr size_t WS_WT_POOL = WS_WT_DOWN + (size_t)2 * 1024 * DFF * 2;
constexpr size_t WS_MOD = WS_WT_POOL + (size_t)4 * 256 * 256 * 2;
constexpr size_t WS_BA = WS_MOD + (size_t)2 * NBC * 6144 * 4;
constexpr size_t WS_GC = WS_BA + (size_t)MP * 32 * 4;
constexpr size_t WS_SSQ = WS_GC + (size_t)TP * 16 * 4;
constexpr size_t WS_U = WS_SSQ + (size_t)TP * 16 * 4 * 4;
constexpr size_t WS_PROJ = WS_U + (size_t)MP * 1024 * 2;
constexpr size_t WS_Q = WS_PROJ + (size_t)MP * NPROJ * 2;
constexpr size_t WS_KT = WS_Q + (size_t)TP * 1024 * 2;
constexpr size_t WS_KCUM = WS_KT + (size_t)TP * 1024 * 2;
constexpr size_t WS_VALT = WS_KCUM + (size_t)TP * 2048 * 2;
constexpr size_t WS_END = WS_VALT + (size_t)TP * 2048 * 2;
constexpr size_t WS_R = WS_Q;
static_assert(WS_END <= (size_t)536870912, "workspace");
static_assert((size_t)MP * 1024 * 4 <= WS_END - WS_Q, "R alias");

constexpr size_t O_Y = 0;
constexpr size_t O_PS = (size_t)TT * 1024;
constexpr size_t O_PCONV = O_PS + (size_t)8 * 16 * 16384;
constexpr size_t O_PPOOL = O_PCONV + (size_t)8 * 3 * CONVD;
constexpr size_t O_SS = O_PPOOL + (size_t)8 * 15 * 1024;
constexpr size_t O_SCONV = O_SS + (size_t)128 * 16 * 16384;
constexpr size_t O_SPOOL = O_SCONV + (size_t)128 * 3 * CONVD;

struct Params {
    const float *x_prompt, *x_sample, *c_prompt, *c_sample, *st_S, *st_conv, *st_pool, *ada_w, *ada_b, *ln_g, *ln_b;
    const float *w_in, *conv_w, *A_log, *dt_bias, *norm_w, *w_out, *pool_w, *pool_scale, *w_up, *w_down;
    float* out; unsigned char* ws; int ph_lo, ph_hi;
};

DI unsigned pk2(float a, float b) { f32x2 v = {a, b}; bf2_t r = __builtin_convertvector(v, bf2_t); return __builtin_bit_cast(unsigned, r); }
DI float bflo(unsigned u) { return __uint_as_float(u << 16); }
DI float bfhi(unsigned u) { return __uint_as_float(u & 0xffff0000u); }
DI float silu_f(float x) { return x / (1.f + __expf(-x)); }
DI float sigmoid_f(float x) { return 1.f / (1.f + __expf(-x)); }
DI float softplus_f(float x) { return fmaxf(x, 0.f) + log1pf(__expf(-fabsf(x))); }
DI u32x4 pack8(const float* f) { u32x4 w; w.x = pk2(f[0], f[1]); w.y = pk2(f[2], f[3]); w.z = pk2(f[4], f[5]); w.w = pk2(f[6], f[7]); return w; }
DI void unpack8(u32x4 w, float* f) { f[0] = bflo(w.x); f[1] = bfhi(w.x); f[2] = bflo(w.y); f[3] = bfhi(w.y); f[4] = bflo(w.z); f[5] = bfhi(w.z); f[6] = bflo(w.w); f[7] = bfhi(w.w); }
DI int otid() { int t = threadIdx.x; asm volatile("" : "+v"(t)); return t; }
DI int batch_of(int row) { return row < TP ? (row >> 11) : (8 + row - TP); }
#define MFMA16(a, b, c) __builtin_amdgcn_mfma_f32_16x16x32_bf16((a), (b), (c), 0, 0, 0)

namespace pg8 {
constexpr int BM = 256, BK = 64, HALF = 128, HTB = HALF * BK * 2, STAGE_BYTES = 8 * HTB, NXCD = 8, WGM = 8;
DI int lds_byte(int r, int c) { const int st = (r >> 4) * 2 + (c >> 5), rr = r & 15, cc = c & 31, ob = rr * 64 + cc * 2; return st * 1024 + (ob ^ (((ob >> 9) & 1) << 5)); }
DI void stage_rc(int b, int& R, int& C) { const int st = b / 1024, sb = b % 1024, swz = sb ^ (((sb >> 9) & 1) << 5); R = (st >> 1) * 16 + swz / 64; C = (st & 1) * 32 + (swz % 64) / 2; }
DI int perm32(int rho) { const int n = rho >> 4, i = rho & 15; return 8 * (i >> 2) + 4 * n + (i & 3); }
struct Unit { int pm, pn; };
struct Gemm { const bf16_t* A; const bf16_t* Bt; int lda, ldb, K; int a_pn_off; };
struct StaticOrder {
    int nM, nN, nwg, G, c;
    DI void init(int M, int N, int G_, int c_) { nM = M / BM; nN = N / BM; nwg = nM * nN; G = G_; c = c_; }
    DI bool next(int i, Unit& u) const {
        const long L = (long)i * G + c; if (L >= nwg) return false;
        int wgid = (int)L; { const int q = nwg / NXCD, r = nwg % NXCD, xcd = wgid % NXCD, off = wgid / NXCD; wgid = (xcd < r ? xcd * (q + 1) : r * (q + 1) + (xcd - r) * q) + off; }
        const int nig = WGM * nN, gid = wgid / nig, fm = gid * WGM, gsz = (nM - fm) < WGM ? (nM - fm) : WGM;
        u.pm = fm + ((wgid % nig) % gsz); u.pn = (wgid % nig) / gsz; return true;
    }
};
template <class Epi>
DI void gemm_phase(LAS unsigned char* lds, const Gemm g, const StaticOrder& S, const Epi& E) {
    const int tid = otid(), wid = __builtin_amdgcn_readfirstlane(tid >> 6), lane = tid & 63, wr = wid >> 2, wc = wid & 3, fr = lane & 15, fq = lane >> 4;
    const int K = g.K, nt = K / BK;
    unsigned voffA[2], voffB[2];
#pragma unroll
    for (int i = 0; i < 2; ++i) { int R, C; stage_rc(tid * 16 + i * 8192, R, C); const int Rb = Epi::PERM ? ((R & ~31) + perm32(R & 31)) : R;
        voffA[i] = (unsigned)(R * g.lda + C) * 2u; voffB[i] = (unsigned)(Rb * g.ldb + C) * 2u; }
    const size_t kstep = (size_t)(BK * 2);
    const size_t hA = (size_t)HALF * g.lda * 2, hB = (size_t)HALF * g.ldb * 2;
    const unsigned ldsw = (unsigned)wid * 1024u;
    const int aoff = lds_byte(wr * 64 + fr, fq * 8), boff = lds_byte(wc * 32 + fr, fq * 8);
#define PG8_SA(b, h) (((b) * 2 + (h)) * HTB)
#define PG8_SB(b, h) ((4 + (b) * 2 + (h)) * HTB)
#define PG8_STAGE(bufoff, gbase, voff) do { _Pragma("unroll") for (int _i = 0; _i < 2; ++_i) \
        __builtin_amdgcn_global_load_lds((const unsigned*)((const char*)(gbase) + (voff)[_i]), (LAS unsigned*)(lds + (bufoff) + ldsw + _i * 8192), 16, 0, 0); } while (0)
#define PG8_LDA(dst, b, h) do { _Pragma("unroll") for (int m = 0; m < 4; ++m) _Pragma("unroll") for (int k = 0; k < 2; ++k) dst[m][k] = *(const LAS bf16x8*)(lds + PG8_SA(b, h) + aoff + m * 2048 + k * 1024); } while (0)
#define PG8_LDB(dst, b, h) do { _Pragma("unroll") for (int n = 0; n < 2; ++n) _Pragma("unroll") for (int k = 0; k < 2; ++k) dst[n][k] = *(const LAS bf16x8*)(lds + PG8_SB(b, h) + boff + n * 2048 + k * 1024); } while (0)
#define PG8_MMA(ai, bj, At, Bt) do { __builtin_amdgcn_s_setprio(1); _Pragma("unroll") for (int m = 0; m < 4; ++m) _Pragma("unroll") for (int n = 0; n < 2; ++n) _Pragma("unroll") for (int k = 0; k < 2; ++k) \
        acc[ai][bj][m][n] = __builtin_amdgcn_mfma_f32_16x16x32_bf16(Bt[n][k], At[m][k], acc[ai][bj][m][n], 0, 0, 0); __builtin_amdgcn_s_setprio(0); } while (0)
#define PG8_WAIT_V(n) asm volatile("s_waitcnt vmcnt(" #n ")" ::: "memory")
#define PG8_WAIT_L(n) asm volatile("s_waitcnt lgkmcnt(" #n ")" ::: "memory")
#define PG8_BAR __builtin_amdgcn_s_barrier()
#define PG8_SCHED __builtin_amdgcn_sched_barrier(0)
    Unit cur, nxt; int ui = 0;
    if (!S.next(0, cur)) return;
    f32x4 acc[2][2][4][2];
#pragma unroll
    for (int a = 0; a < 2; ++a)
#pragma unroll
        for (int b = 0; b < 2; ++b)
#pragma unroll
            for (int m = 0; m < 4; ++m)
#pragma unroll
                for (int n = 0; n < 2; ++n) acc[a][b][m][n] = (f32x4){0.f, 0.f, 0.f, 0.f};
    bf16x8 At[4][2], B0[2][2], B1[2][2];
    const char* cA = (const char*)g.A + (size_t)cur.pm * 2 * hA + (size_t)cur.pn * g.a_pn_off; const char* cB = (const char*)g.Bt + (size_t)cur.pn * 2 * hB;
    PG8_STAGE(PG8_SB(0, 0), cB, voffB); PG8_STAGE(PG8_SB(0, 1), cB + hB, voffB); PG8_STAGE(PG8_SA(0, 0), cA, voffA); PG8_STAGE(PG8_SA(0, 1), cA + hA, voffA);
    if (wr == 1) PG8_BAR;
    PG8_WAIT_V(2); PG8_BAR;
    PG8_STAGE(PG8_SB(1, 0), cB + kstep, voffB); PG8_STAGE(PG8_SA(1, 0), cA + kstep, voffA); PG8_STAGE(PG8_SB(1, 1), cB + hB + kstep, voffB);
    PG8_WAIT_V(6); PG8_BAR;
    for (;;) {
        const bool has_next = S.next(ui + 1, nxt);
        const char* nA = has_next ? (const char*)g.A + (size_t)nxt.pm * 2 * hA + (size_t)nxt.pn * g.a_pn_off : cA; const char* nB = has_next ? (const char*)g.Bt + (size_t)nxt.pn * 2 * hB : cB;
        for (int t = 0; t < nt; t += 2) {
            const bool last = (t == nt - 2);
            const char* a1 = cA + (size_t)(t + 1) * kstep;
            const char* a2 = last ? nA : cA + (size_t)(t + 2) * kstep; const char* b2 = last ? nB : cB + (size_t)(t + 2) * kstep;
            const char* a3 = a2 + kstep; const char* b3 = b2 + kstep;
            PG8_LDB(B0, 0, 0); PG8_LDB(B1, 0, 1); PG8_SCHED; PG8_LDA(At, 0, 0); PG8_STAGE(PG8_SA(1, 1), a1 + hA, voffA);
            PG8_WAIT_V(8); PG8_WAIT_L(0); PG8_BAR; PG8_MMA(0, 0, At, B0); PG8_MMA(0, 1, At, B1); PG8_BAR; PG8_SCHED;
            PG8_LDA(At, 0, 1); PG8_STAGE(PG8_SB(0, 0), b2, voffB); PG8_STAGE(PG8_SB(0, 1), b2 + hB, voffB); PG8_STAGE(PG8_SA(0, 0), a2, voffA);
            PG8_WAIT_V(8); PG8_WAIT_L(0); PG8_BAR; PG8_MMA(1, 0, At, B0); PG8_MMA(1, 1, At, B1); PG8_BAR; PG8_SCHED;
            PG8_LDB(B0, 1, 0); PG8_LDB(B1, 1, 1); PG8_SCHED; PG8_LDA(At, 1, 0); PG8_STAGE(PG8_SA(0, 1), a2 + hA, voffA);
            PG8_WAIT_V(8); PG8_WAIT_L(0); PG8_BAR; PG8_MMA(0, 0, At, B0); PG8_MMA(0, 1, At, B1); PG8_BAR; PG8_SCHED;
            PG8_LDA(At, 1, 1); PG8_STAGE(PG8_SB(1, 0), b3, voffB); PG8_STAGE(PG8_SB(1, 1), b3 + hB, voffB); PG8_STAGE(PG8_SA(1, 0), a3, voffA);
            PG8_WAIT_V(8); PG8_WAIT_L(0); PG8_BAR; PG8_MMA(1, 0, At, B0); PG8_MMA(1, 1, At, B1); PG8_BAR; PG8_SCHED;
        }
        if (wr == 0) PG8_BAR;
        E(acc, cur, wr, wc, fr, fq);
        if (!has_next) break;
#pragma unroll
        for (int a = 0; a < 2; ++a)
#pragma unroll
            for (int b = 0; b < 2; ++b)
#pragma unroll
                for (int m = 0; m < 4; ++m)
#pragma unroll
                    for (int n = 0; n < 2; ++n) acc[a][b][m][n] = (f32x4){0.f, 0.f, 0.f, 0.f};
        cur = nxt; cA = nA; cB = nB; ++ui;
        if (wr == 1) PG8_BAR;
    }
    PG8_WAIT_V(0);
    PG8_BAR;
#undef PG8_SA
#undef PG8_SB
#undef PG8_STAGE
#undef PG8_LDA
#undef PG8_LDB
#undef PG8_MMA
#undef PG8_WAIT_V
#undef PG8_WAIT_L
#undef PG8_BAR
#undef PG8_SCHED
}

struct EpiInProj {
    static constexpr bool PERM = true;
    bf16_t* proj; float* ba;
    DI void operator()(const f32x4 (&acc)[2][2][4][2], const Unit& u, int wr, int wc, int fr, int fq) const {
        const int row0 = u.pm * BM + wr * 64 + fr;
        if (u.pn < 24) {
            const int col0 = u.pn * BM + wc * 32 + 8 * fq;
#pragma unroll
            for (int ai = 0; ai < 2; ++ai)
#pragma unroll
                for (int m = 0; m < 4; ++m) { bf16_t* rowp = proj + (size_t)(row0 + ai * HALF + m * 16) * NPROJ + col0;
#pragma unroll
                    for (int bj = 0; bj < 2; ++bj) { const f32x4 v0 = acc[ai][bj][m][0], v1 = acc[ai][bj][m][1];
                        u32x4 w; w.x = pk2(v0[0], v0[1]); w.y = pk2(v0[2], v0[3]); w.z = pk2(v1[0], v1[1]); w.w = pk2(v1[2], v1[3]);
                        *(u32x4*)(rowp + bj * HALF) = w; } }
        } else if (wc == 0) {
#pragma unroll
            for (int ai = 0; ai < 2; ++ai)
#pragma unroll
                for (int m = 0; m < 4; ++m) { float* rowp = ba + (size_t)(row0 + ai * HALF + m * 16) * 32 + 8 * fq;
                    *(f32x4*)(rowp) = acc[ai][0][m][0]; *(f32x4*)(rowp + 4) = acc[ai][0][m][1]; }
        }
    }
};
struct EpiRes {
    static constexpr bool PERM = false;
    const float* res_p; const float* res_s;
    const float* gate;
    const float* cscale; float* R;
    DI void operator()(const f32x4 (&acc)[2][2][4][2], const Unit& u, int wr, int wc, int fr, int fq) const {
        const int row0 = u.pm * BM + wr * 64 + fr, col0 = u.pn * BM + wc * 32 + 4 * fq;
        f32x4 cs[2][2];
#pragma unroll
        for (int bj = 0; bj < 2; ++bj)
#pragma unroll
            for (int n = 0; n < 2; ++n) cs[bj][n] = cscale ? *(const f32x4*)(cscale + col0 + bj * HALF + n * 16) : (f32x4){1.f, 1.f, 1.f, 1.f};
#pragma unroll
        for (int ai = 0; ai < 2; ++ai)
#pragma unroll
            for (int m = 0; m < 4; ++m) { const int row = row0 + ai * HALF + m * 16;
                if (row < TT) {
                    const float* rp = (row < TP ? res_p + (size_t)row * D : res_s + (size_t)(row - TP) * D) + col0;
                    const float* gp = gate + (size_t)batch_of(row) * 6144 + col0;
                    float* op = R + (size_t)row * D + col0;
#pragma unroll
                    for (int bj = 0; bj < 2; ++bj)
#pragma unroll
                        for (int n = 0; n < 2; ++n) { const f32x4 rv = *(const f32x4*)(rp + bj * HALF + n * 16), gv = *(const f32x4*)(gp + bj * HALF + n * 16);
                            *(f32x4*)(op + bj * HALF + n * 16) = rv * DN_ALPHA + gv * (acc[ai][bj][m][n] * cs[bj][n]); }
                } }
    }
};
struct EpiSwiGLU {
    static constexpr bool PERM = true;
    bf16_t* H;
    DI void operator()(const f32x4 (&acc)[2][2][4][2], const Unit& u, int wr, int wc, int fr, int fq) const {
        const int row0 = u.pm * BM + wr * 64 + fr, col0 = u.pn * HALF + wc * 32 + 8 * fq;
#pragma unroll
        for (int ai = 0; ai < 2; ++ai)
#pragma unroll
            for (int m = 0; m < 4; ++m) { float h[8];
#pragma unroll
                for (int n = 0; n < 2; ++n)
#pragma unroll
                    for (int j = 0; j < 4; ++j) h[n * 4 + j] = silu_f(acc[ai][0][m][n][j]) * acc[ai][1][m][n][j];
                *(u32x4*)(H + (size_t)(row0 + ai * HALF + m * 16) * DFF + col0) = pack8(h); }
    }
};
}

DI void transpose_tile(const float* __restrict__ src, int N, int k0, int n0, bf16_t* __restrict__ dst, int ldd, int drow0, LAS float* tile, int tid) {
#pragma unroll
    for (int i = 0; i < 2; ++i) { const int kr = (tid >> 4) + 32 * i, c4 = (tid & 15) * 4; f32x4 v = {0.f, 0.f, 0.f, 0.f};
        if (n0 + c4 < N) v = *(const f32x4*)(src + (size_t)(k0 + kr) * N + n0 + c4);
        LAS float* t = tile + kr * 65 + c4; t[0] = v[0]; t[1] = v[1]; t[2] = v[2]; t[3] = v[3]; }
    __syncthreads();
    const int n = tid >> 3, kc = (tid & 7) * 8; float f[8];
#pragma unroll
    for (int i = 0; i < 8; ++i) f[i] = tile[(kc + i) * 65 + n];
    *(u32x4*)(dst + (size_t)(drow0 + n) * ldd + k0 + kc) = pack8(f);
    __syncthreads();
}
DI void mod_item(const Params& p, int item, LAS unsigned char* lds, int tid) {
    const int l = item / 96, nb = item % 96, n0 = nb * 64;
    const int w = tid >> 6, lane = tid & 63, cgp = w & 1, ks = w >> 1, fr = lane & 15, fq = lane >> 4;
    const float* W = p.ada_w + (size_t)l * 1024 * 6144 + n0 + 32 * cgp + 2 * fr;
    f32x4 acc[9][2];
#pragma unroll
    for (int mb = 0; mb < 9; ++mb) { acc[mb][0] = (f32x4){0.f, 0.f, 0.f, 0.f}; acc[mb][1] = (f32x4){0.f, 0.f, 0.f, 0.f}; }
    for (int st = 0; st < 8; ++st) {
        const int k0 = ks * 256 + st * 32 + fq * 8;
        f32x2 wv[8];
#pragma unroll
        for (int i = 0; i < 8; ++i) wv[i] = *(const f32x2*)(W + (size_t)(k0 + i) * 6144);
        u32x4 t0, t1; t0.x = pk2(wv[0].x, wv[1].x); t0.y = pk2(wv[2].x, wv[3].x); t0.z = pk2(wv[4].x, wv[5].x); t0.w = pk2(wv[6].x, wv[7].x);
        t1.x = pk2(wv[0].y, wv[1].y); t1.y = pk2(wv[2].y, wv[3].y); t1.z = pk2(wv[4].y, wv[5].y); t1.w = pk2(wv[6].y, wv[7].y);
        const bf16x8 b0 = __builtin_bit_cast(bf16x8, t0), b1 = __builtin_bit_cast(bf16x8, t1);
#pragma unroll
        for (int mb = 0; mb < 9; ++mb) { const int row = 16 * mb + fr; u32x4 aw = {0u, 0u, 0u, 0u};
            if (row < NBC) { const float* cp = (row < 8 ? p.c_prompt + (size_t)row * D : p.c_sample + (size_t)(row - 8) * D) + k0;
                const f32x4 c0 = *(const f32x4*)cp, c1 = *(const f32x4*)(cp + 4);
                aw.x = pk2(silu_f(c0[0]), silu_f(c0[1])); aw.y = pk2(silu_f(c0[2]), silu_f(c0[3])); aw.z = pk2(silu_f(c1[0]), silu_f(c1[1])); aw.w = pk2(silu_f(c1[2]), silu_f(c1[3])); }
            const bf16x8 a = __builtin_bit_cast(bf16x8, aw);
            acc[mb][0] = MFMA16(a, b0, acc[mb][0]); acc[mb][1] = MFMA16(a, b1, acc[mb][1]); }
    }
    LAS f32x4* red = (LAS f32x4*)lds;
    if (ks > 0) {
#pragma unroll
        for (int mb = 0; mb < 9; ++mb)
#pragma unroll
            for (int e = 0; e < 2; ++e) red[((((ks - 1) * 2 + cgp) * 9 + mb) * 2 + e) * 64 + lane] = acc[mb][e];
    }
    __syncthreads();
    if (ks == 0) {
        float* mod = (float*)(p.ws + WS_MOD);
#pragma unroll
        for (int mb = 0; mb < 9; ++mb) {
#pragma unroll
            for (int e = 0; e < 2; ++e)
#pragma unroll
                for (int s = 0; s < 3; ++s) acc[mb][e] += red[(((s * 2 + cgp) * 9 + mb) * 2 + e) * 64 + lane];
            const int col = n0 + 32 * cgp + 2 * fr; const f32x2 bb = *(const f32x2*)(p.ada_b + (size_t)l * 6144 + col);
#pragma unroll
            for (int r = 0; r < 4; ++r) { const int row = 16 * mb + 4 * fq + r;
                if (row < NBC) { f32x2 o = {acc[mb][0][r] + bb.x, acc[mb][1][r] + bb.y}; *(f32x2*)(mod + ((size_t)(l * NBC + row)) * 6144 + col) = o; } }
        }
    }
    __syncthreads();
}
DI void phase0(const Params& p, LAS unsigned char* lds) {
    const int tid = otid(), G = gridDim.x, bx = blockIdx.x;
    for (int it = bx; it < 192; it += G) mod_item(p, it, lds, tid);
    LAS float* tile = (LAS float*)lds;
    for (int t = bx; t < 6352; t += G) {
        const float* src; int N, k0, n0, ldd, drow0; bf16_t* dst;
        if (t < 1552) { const int kt = t % 16, nt = t / 16; src = p.w_in; N = INDIM; k0 = 64 * kt; n0 = 64 * nt; dst = (bf16_t*)(p.ws + WS_WT_IN); ldd = 1024; drow0 = n0; }
        else if (t < 2064) { const int q = t - 1552, kt = q % 32, nt = q / 32; src = p.w_out; N = 1024; k0 = 64 * kt; n0 = 64 * nt; dst = (bf16_t*)(p.ws + WS_WT_OUT); ldd = 2048; drow0 = n0; }
        else if (t < 4880) { const int q = t - 2064, l = q / 1408, r = q % 1408, kt = r % 16, nt = r / 16; src = p.w_up + (size_t)l * 1024 * 5632; N = 5632; k0 = 64 * kt; n0 = 64 * nt;
            dst = (bf16_t*)(p.ws + WS_WT_UP) + (size_t)l * 5632 * 1024; ldd = 1024;
            drow0 = n0 < DFF ? 256 * (n0 / 128) + (n0 % 128) : 256 * ((n0 - DFF) / 128) + 128 + ((n0 - DFF) % 128); }
        else if (t < 6288) { const int q = t - 4880, l = q / 704, r = q % 704, kt = r % 44, nt = r / 44; src = p.w_down + (size_t)l * DFF * 1024; N = 1024; k0 = 64 * kt; n0 = 64 * nt;
            dst = (bf16_t*)(p.ws + WS_WT_DOWN) + (size_t)l * 1024 * DFF; ldd = DFF; drow0 = n0; }
        else { const int q = t - 6288, g = q / 16, r = q % 16, kt = r % 4, nt = r / 4; src = p.pool_w + (size_t)g * 65536; N = 256; k0 = 64 * kt; n0 = 64 * nt;
            dst = (bf16_t*)(p.ws + WS_WT_POOL) + (size_t)g * 65536; ldd = 256; drow0 = n0; }
        transpose_tile(src, N, k0, n0, dst, ldd, drow0, tile, tid);
    }
    { u32x4* z = (u32x4*)((bf16_t*)(p.ws + WS_WT_IN) + (size_t)6208 * 1024); const u32x4 zz = {0u, 0u, 0u, 0u};
      for (int i = bx * NTHR + tid; i < 192 * 1024 / 8; i += G * NTHR) z[i] = zz; }
}

DI void phase_u0(const Params& p) {
    const float* mod = (const float*)(p.ws + WS_MOD); bf16_t* U = (bf16_t*)(p.ws + WS_U);
    const int tid0 = otid();
    for (int i = blockIdx.x * NTHR + tid0; i < MP * 128; i += gridDim.x * NTHR) {
        const int row = i >> 7, c = (i & 127) * 8; float o[8];
        if (row < TT) { const float* xp = (row < TP ? p.x_prompt + (size_t)row * D : p.x_sample + (size_t)(row - TP) * D) + c; const float* mp = mod + (size_t)batch_of(row) * 6144 + c;
            const f32x4 x0 = *(const f32x4*)xp, x1 = *(const f32x4*)(xp + 4), h0 = *(const f32x4*)mp, h1 = *(const f32x4*)(mp + 4), s0 = *(const f32x4*)(mp + 1024), s1 = *(const f32x4*)(mp + 1028);
#pragma unroll
            for (int j = 0; j < 4; ++j) { o[j] = x0[j] * (1.f + s0[j]) + h0[j]; o[4 + j] = x1[j] * (1.f + s1[j]) + h1[j]; }
        } else {
#pragma unroll
            for (int j = 0; j < 8; ++j) o[j] = 0.f; }
        *(u32x4*)(U + (size_t)row * D + c) = pack8(o);
    }
}

template <int MODE>
DI void phase_ln(const Params& p, const float* g, const float* bb, const float* modsh  ) {
    const float* R = (const float*)(p.ws + WS_R); float* Y = p.out + O_Y; bf16_t* U = (bf16_t*)(p.ws + WS_U);
    const int tidl = otid(); const int lane = tidl & 63, w = tidl >> 6;
    for (int row = blockIdx.x * 8 + w; row < TT; row += gridDim.x * 8) {
        f32x4 x[4]; float s = 0.f;
#pragma unroll
        for (int i = 0; i < 4; ++i) { x[i] = *(const f32x4*)(R + (size_t)row * D + i * 256 + lane * 4); s += (x[i][0] + x[i][1]) + (x[i][2] + x[i][3]); }
#pragma unroll
        for (int o = 32; o >= 1; o >>= 1) s += __shfl_xor(s, o);
        const float mu = s * (1.f / 1024.f); float q = 0.f;
#pragma unroll
        for (int i = 0; i < 4; ++i) { x[i] = x[i] - mu; q += (x[i][0] * x[i][0] + x[i][1] * x[i][1]) + (x[i][2] * x[i][2] + x[i][3] * x[i][3]); }
#pragma unroll
        for (int o = 32; o >= 1; o >>= 1) q += __shfl_xor(q, o);
        const float rstd = rsqrtf(q * (1.f / 1024.f) + 1e-5f);
        const float* mp = MODE ? modsh + (size_t)batch_of(row) * 6144 : nullptr;
#pragma unroll
        for (int i = 0; i < 4; ++i) { const int c = i * 256 + lane * 4; const f32x4 gv = *(const f32x4*)(g + c), bv = *(const f32x4*)(bb + c);
            const f32x4 y = x[i] * rstd * gv + bv; *(f32x4*)(Y + (size_t)row * D + c) = y;
            if (MODE) { const f32x4 sh = *(const f32x4*)(mp + c), sc = *(const f32x4*)(mp + 1024 + c); const f32x4 u = y * (sc + 1.f) + sh;
                u32x2 wv; wv.x = pk2(u[0], u[1]); wv.y = pk2(u[2], u[3]); *(u32x2*)(U + (size_t)row * D + c) = wv; } }
    }
}

DI void phase_pool(const Params& p) {
    const float* Y = p.out + O_Y; const float* mod = (const float*)(p.ws + WS_MOD) + (size_t)NBC * 6144;
    bf16_t* U = (bf16_t*)(p.ws + WS_U);
    const int tid = otid(), c = tid * 2, gi = c >> 8, w = 2 << gi;
    for (int it = blockIdx.x; it < 256; it += gridDim.x) {
        const int b = it >> 5, t0 = (it & 31) * 64, rb = b * SEQ;
        const f32x2 sh = *(const f32x2*)(mod + (size_t)b * 6144 + c), sc = *(const f32x2*)(mod + (size_t)b * 6144 + 1024 + c);
        f32x2 sum = {0.f, 0.f};
        for (int j = 1; j < w; ++j) { const int t = t0 - j; if (t >= 0) { const f32x2 y = *(const f32x2*)(Y + (size_t)(rb + t) * D + c); sum += y * (sc + 1.f) + sh; } }
        for (int t = t0; t < t0 + 64; ++t) {
            const f32x2 y = *(const f32x2*)(Y + (size_t)(rb + t) * D + c); const f32x2 u = y * (sc + 1.f) + sh; sum += u;
            const float cnt = (float)(t + 1 < w ? t + 1 : w); const f32x2 pl = sum / cnt - u;
            *(unsigned*)(U + (size_t)(rb + t) * D + c) = pk2(pl.x, pl.y);
            if (t >= SEQ - 15) *(f32x2*)(p.out + O_PPOOL + ((size_t)b * 15 + (t - (SEQ - 15))) * D + c) = u;
            const int tl = t - w + 1; if (tl >= 0) { const f32x2 yl = *(const f32x2*)(Y + (size_t)(rb + tl) * D + c); sum -= yl * (sc + 1.f) + sh; }
        }
    }
    for (int sb = blockIdx.x; sb < TS; sb += gridDim.x) {
        const int b = 8 + sb, row = TP + sb;
        const f32x2 sh = *(const f32x2*)(mod + (size_t)b * 6144 + c), sc = *(const f32x2*)(mod + (size_t)b * 6144 + 1024 + c);
        const f32x2 y = *(const f32x2*)(Y + (size_t)row * D + c); const f32x2 u = y * (sc + 1.f) + sh; f32x2 sum = u;
        const float* pv = p.st_pool + (size_t)sb * 15 * D + c;
        for (int j = 1; j < w; ++j) sum += *(const f32x2*)(pv + (size_t)(15 - j) * D);
        const f32x2 pl = sum / (float)w - u; *(unsigned*)(U + (size_t)row * D + c) = pk2(pl.x, pl.y);
        float* so = p.out + O_SPOOL + (size_t)sb * 15 * D + c;
        for (int j = 0; j < 14; ++j) *(f32x2*)(so + (size_t)j * D) = *(const f32x2*)(pv + (size_t)(j + 1) * D);
        *(f32x2*)(so + (size_t)14 * D) = u;
    }
}

DI bf16x8 packB(const f32x4& lo, const f32x4& hi) { u32x4 w = {pk2(lo[0], lo[1]), pk2(lo[2], lo[3]), pk2(hi[0], hi[1]), pk2(hi[2], hi[3])}; return __builtin_bit_cast(bf16x8, w); }
DI bf16x8 lds2x4(const LAS bf16_t* p0) { const u32x2 a = *(const LAS u32x2*)p0, b = *(const LAS u32x2*)(p0 + 16); u32x4 w = {a.x, a.y, b.x, b.y}; return __builtin_bit_cast(bf16x8, w); }
DI void prep_item(const Params& p, int item, LAS unsigned char* lds) {
    const int tid = otid(), lane = tid & 63, w = tid >> 6;
    const int b = item >> 8, hk = (item >> 5) & 7, n = item & 31, t0 = n * 64, R0 = b * SEQ + t0;
    const bf16_t* proj = (const bf16_t*)(p.ws + WS_PROJ); const float* ba = (const float*)(p.ws + WS_BA);
    LAS bf16_t* QL = (LAS bf16_t*)lds; LAS bf16_t* KL = (LAS bf16_t*)(lds + 17408); LAS bf16_t* KTL = (LAS bf16_t*)(lds + 34816); LAS bf16_t* VTL = (LAS bf16_t*)(lds + 53248);
    LAS bf16_t* NB = (LAS bf16_t*)(lds + 90112); LAS bf16_t* TB = (LAS bf16_t*)(lds + 108544); LAS float* GCL = (LAS float*)(lds + 114688); LAS float* BL = (LAS float*)(lds + 115200); LAS float* SCL = (LAS float*)(lds + 115712);
    {
        const int tg = w, cgi = lane;
        const int cls = cgi < 16 ? 0 : (cgi < 32 ? 1 : 2);
        const int col = cls == 0 ? hk * 128 + cgi * 8 : (cls == 1 ? 1024 + hk * 128 + (cgi - 16) * 8 : 2048 + hk * 256 + (cgi - 32) * 8);
        float y[8][8];
#pragma unroll
        for (int tt = 0; tt < 8; ++tt)
#pragma unroll
            for (int cc = 0; cc < 8; ++cc) y[tt][cc] = 0.f;
        float wj[4][8];
#pragma unroll
        for (int j = 0; j < 4; ++j) { const f32x4 a = *(const f32x4*)(p.conv_w + (size_t)j * CONVD + col), c2 = *(const f32x4*)(p.conv_w + (size_t)j * CONVD + col + 4);
#pragma unroll
            for (int cc = 0; cc < 4; ++cc) { wj[j][cc] = a[cc]; wj[j][4 + cc] = c2[cc]; } }
#pragma unroll
        for (int i = 0; i < 11; ++i) {
            const int t = t0 + 8 * tg - 3 + i; float x[8];
            if (t >= 0) { const u32x4 v = *(const u32x4*)(proj + (size_t)(b * SEQ + t) * NPROJ + col); unpack8(v, x); }
            else {
#pragma unroll
                for (int cc = 0; cc < 8; ++cc) x[cc] = 0.f; }
#pragma unroll
            for (int j = 0; j < 4; ++j) { const int tt = i - j; if (tt >= 0 && tt < 8) {
#pragma unroll
                    for (int cc = 0; cc < 8; ++cc) y[tt][cc] += wj[j][cc] * x[cc]; } }
        }
#pragma unroll
        for (int tt = 0; tt < 8; ++tt) { float ss = 0.f;
#pragma unroll
            for (int cc = 0; cc < 8; ++cc) { y[tt][cc] = silu_f(y[tt][cc]); ss += y[tt][cc] * y[tt][cc]; }
            ss += __shfl_xor(ss, 1); ss += __shfl_xor(ss, 2); ss += __shfl_xor(ss, 4); ss += __shfl_xor(ss, 8);
            if (cls < 2) { const float sc = rsqrtf(ss + 1e-6f) * (cls == 0 ? 0.08838834764831845f : 1.f);
#pragma unroll
                for (int cc = 0; cc < 8; ++cc) y[tt][cc] *= sc; } }
        if (cls == 0) { bf16_t* Qg = (bf16_t*)(p.ws + WS_Q) + ((size_t)(b * 8 + hk) * SEQ + t0 + 8 * tg) * 128 + cgi * 8;
#pragma unroll
            for (int tt = 0; tt < 8; ++tt) { const u32x4 v = pack8(y[tt]); *(LAS u32x4*)(QL + (8 * tg + tt) * 136 + cgi * 8) = v; *(u32x4*)(Qg + (size_t)tt * 128) = v; } }
        else {
            if (cls == 1) {
#pragma unroll
                for (int tt = 0; tt < 8; ++tt) *(LAS u32x4*)(KL + (8 * tg + tt) * 136 + (cgi - 16) * 8) = pack8(y[tt]); }
            LAS bf16_t* TL = cls == 1 ? KTL + (cgi - 16) * 8 * 72 : VTL + (cgi - 32) * 8 * 72;
            bf16_t* KTg = (bf16_t*)(p.ws + WS_KT) + ((size_t)((b * 8 + hk) * 32 + n) * 128 + (cgi - 16) * 8) * 64 + 8 * tg;
#pragma unroll
            for (int cc = 0; cc < 8; ++cc) { float tcol[8];
#pragma unroll
                for (int tt = 0; tt < 8; ++tt) tcol[tt] = y[tt][cc];
                const u32x4 v = pack8(tcol); *(LAS u32x4*)(TL + cc * 72 + ((tg ^ (cgi & 7)) * 8)) = v;
                if (cls == 1) *(u32x4*)(KTg + (size_t)cc * 64) = v; }
        }
        if (w < 2) { const int e = w, h = 2 * hk + e, row = R0 + lane;
            const float bv = ba[(size_t)row * 32 + h], av = ba[(size_t)row * 32 + 16 + h];
            const float beta = sigmoid_f(bv); float g = -__expf(p.A_log[h]) * softplus_f(av + p.dt_bias[h]);
#pragma unroll
            for (int o = 1; o < 64; o <<= 1) { const float t = __shfl_up(g, o); if (lane >= o) g += t; }
            GCL[e * 64 + lane] = g; BL[e * 64 + lane] = beta; SCL[(e * 2 + 0) * 64 + lane] = beta; SCL[(e * 2 + 1) * 64 + lane] = beta * __expf(g);
            ((float*)(p.ws + WS_GC))[(size_t)(b * 16 + h) * SEQ + t0 + lane] = g; }
    }
    __syncthreads();
    {
        const int fr = lane & 15, fq = lane >> 4;
        for (int q = w; q < 32; q += 8) {
            const int type = q >> 4, jt = (q >> 2) & 3, it = q & 3;
            if (it < jt && type == 0) continue;
            f32x4 c = {0.f, 0.f, 0.f, 0.f};
            if (it >= jt) { const LAS bf16_t* XL = type ? QL : KL;
#pragma unroll
                for (int ks = 0; ks < 4; ++ks) { const bf16x8 a = *(const LAS bf16x8*)(KL + (16 * jt + fr) * 136 + 32 * ks + fq * 8), bb = *(const LAS bf16x8*)(XL + (16 * it + fr) * 136 + 32 * ks + fq * 8);
                    c = MFMA16(a, bb, c); } }
            const int i = 16 * it + fr, j0 = 16 * jt + 4 * fq;
#pragma unroll
            for (int e = 0; e < 2; ++e) { const float gi = GCL[e * 64 + i], bi = BL[e * 64 + i]; f32x4 o;
#pragma unroll
                for (int r = 0; r < 4; ++r) { const int j = j0 + r; const float dec = __expf(gi - GCL[e * 64 + j]);
                    o[r] = type ? (i >= j ? c[r] * dec : 0.f) : (i > j ? -bi * c[r] * dec : 0.f); }
                u32x2 wv; wv.x = pk2(o[0], o[1]); wv.y = pk2(o[2], o[3]);
                if (type == 0) *(LAS u32x2*)(NB + (e * 64 + i) * 72 + j0) = wv;
                else *(u32x2*)((bf16_t*)(p.ws + WS_U) + ((size_t)((b * 16 + 2 * hk + e) * 32 + n) * 64 + i) * 64 + j0) = wv; }
        }
    }
    __syncthreads();
    {
        const int e = w >> 2, blk = w & 3, c = lane & 15;
        const LAS bf16_t* nb = NB + (e * 64 + 16 * blk) * 72 + 16 * blk;
        float T[16]; T[0] = c == 0 ? 1.f : 0.f;
#pragma unroll
        for (int i = 1; i < 16; ++i) { float f[16]; unpack8(*(const LAS u32x4*)(nb + i * 72), f); unpack8(*(const LAS u32x4*)(nb + i * 72 + 8), f + 8);
            float a = c == i ? 1.f : 0.f;
#pragma unroll
            for (int j = 0; j < i; ++j) a += f[j] * T[j];
            T[i] = a; }
        if (lane < 16) { LAS bf16_t* tb = TB + ((e * 4 + blk) * 16) * 24 + c;
#pragma unroll
            for (int i = 0; i < 16; ++i) tb[i * 24] = (bf16_t)(pk2(T[i], 0.f) & 0xffffu); }
    }
    __syncthreads();
    {
        const int fr = lane & 15, fq = lane >> 4;
        const int e = w >> 2, part = (w >> 1) & 1, h = 2 * hk + e;
        const LAS float* sc = SCL + (e * 2 + part) * 64;
        const u32x2 z2 = {0u, 0u};
        bf16x8 At[4];
#pragma unroll
        for (int ib = 0; ib < 4; ++ib) { const u32x2 t = *(const LAS u32x2*)(TB + ((e * 4 + ib) * 16 + fr) * 24 + 4 * fq); const u32x4 wv = {t.x, t.y, 0u, 0u}; At[ib] = __builtin_bit_cast(bf16x8, wv); }
        const LAS bf16_t* nbe = NB + (e * 64 + fr) * 72 + 4 * fq;
        const u32x2 n10 = *(const LAS u32x2*)(nbe + 16 * 72), n20 = *(const LAS u32x2*)(nbe + 32 * 72), n21 = *(const LAS u32x2*)(nbe + 32 * 72 + 16);
        const u32x2 n30 = *(const LAS u32x2*)(nbe + 48 * 72), n31 = *(const LAS u32x2*)(nbe + 48 * 72 + 16), n32 = *(const LAS u32x2*)(nbe + 48 * 72 + 32);
        const bf16x8 An1 = __builtin_bit_cast(bf16x8, ((u32x4){n10.x, n10.y, 0u, 0u})), An2 = __builtin_bit_cast(bf16x8, ((u32x4){n20.x, n20.y, n21.x, n21.y}));
        const bf16x8 An3a = __builtin_bit_cast(bf16x8, ((u32x4){n30.x, n30.y, n31.x, n31.y})), An3b = __builtin_bit_cast(bf16x8, ((u32x4){n32.x, n32.y, 0u, 0u}));
        const f32x4 zero4 = {0.f, 0.f, 0.f, 0.f};
#pragma unroll
        for (int u = 0; u < 4; ++u) {
            const int col = 16 * ((w & 1) * 4 + u) + fr, rw = part ? col : e * 128 + col, sw = (rw >> 3) & 7;
            const LAS bf16_t* src = (part ? KTL : VTL) + rw * 72 + 4 * (fq & 1);
            f32x4 Y[4];
#pragma unroll
            for (int ib = 0; ib < 4; ++ib) { const u32x2 rv = *(const LAS u32x2*)(src + (((2 * ib + (fq >> 1)) ^ sw) * 8)); const f32x4 sv = *(const LAS f32x4*)(sc + 16 * ib + 4 * fq);
                Y[ib] = (f32x4){bflo(rv.x) * sv[0], bfhi(rv.x) * sv[1], bflo(rv.y) * sv[2], bfhi(rv.y) * sv[3]}; }
            const f32x4 X0 = MFMA16(At[0], packB(Y[0], zero4), zero4);
            const f32x4 Y1 = MFMA16(An1, packB(X0, zero4), Y[1]);
            const f32x4 X1 = MFMA16(At[1], packB(Y1, zero4), zero4);
            const bf16x8 X01 = packB(X0, X1);
            const f32x4 Y2 = MFMA16(An2, X01, Y[2]);
            const f32x4 X2 = MFMA16(At[2], packB(Y2, zero4), zero4);
            f32x4 Y3 = MFMA16(An3a, X01, Y[3]); Y3 = MFMA16(An3b, packB(X2, zero4), Y3);
            const f32x4 X3 = MFMA16(At[3], packB(Y3, zero4), zero4);
            const f32x4 X[4] = {X0, X1, X2, X3};
            if (part == 0) { bf16_t* vt = (bf16_t*)(p.ws + WS_VALT) + ((size_t)((b * 16 + h) * 32 + n) * 128 + col) * 64 + 4 * fq;
#pragma unroll
                for (int ib = 0; ib < 4; ++ib) { u32x2 wv; wv.x = pk2(X[ib][0], X[ib][1]); wv.y = pk2(X[ib][2], X[ib][3]); *(u32x2*)(vt + 16 * ib) = wv; } }
            else { bf16_t* kc = (bf16_t*)(p.ws + WS_KCUM) + ((size_t)(b * 16 + h) * SEQ + t0 + 4 * fq) * 128 + col;
#pragma unroll
                for (int ib = 0; ib < 4; ++ib)
#pragma unroll
                    for (int r = 0; r < 4; ++r) kc[(size_t)(16 * ib + r) * 128] = (bf16_t)(pk2(X[ib][r], 0.f) & 0xffffu); }
        }
        (void)z2;
    }
    __syncthreads();
}
DI void phase_prep(const Params& p, LAS unsigned char* lds) {
    for (int it = blockIdx.x; it < 2048; it += gridDim.x) prep_item(p, it, lds);
    const bf16_t* proj = (const bf16_t*)(p.ws + WS_PROJ);
    const int tidc = otid();
    for (int i = blockIdx.x * NTHR + tidc; i < 8 * 3 * 512; i += gridDim.x * NTHR) { const int c = (i & 511) * 8, bj = i >> 9, b = bj / 3, j = bj % 3;
        const u32x4 v = *(const u32x4*)(proj + (size_t)(b * SEQ + SEQ - 3 + j) * NPROJ + c); float f[8]; unpack8(v, f);
        float* o = p.out + O_PCONV + (size_t)bj * CONVD + c; *(f32x4*)o = (f32x4){f[0], f[1], f[2], f[3]}; *(f32x4*)(o + 4) = (f32x4){f[4], f[5], f[6], f[7]}; }
}

DI void scan_bh(const Params& p, int bh, LAS unsigned char* lds) {
    const int tid = otid(), lane = tid & 63, w = __builtin_amdgcn_readfirstlane(tid >> 6), fr = lane & 15, fq = lane >> 4;
    const int b = bh >> 4, h = bh & 15, hk = h >> 1;
    bf16_t* OG = (bf16_t*)(p.out);
    const bf16_t* KCg = (const bf16_t*)(p.ws + WS_KCUM) + (size_t)bh * SEQ * 128;
    const bf16_t* QQg = (const bf16_t*)(p.ws + WS_Q) + (size_t)(b * 8 + hk) * SEQ * 128;
    const bf16_t* ATg = (const bf16_t*)(p.ws + WS_U) + (size_t)bh * 32 * 4096;
    const bf16_t* KTg = (const bf16_t*)(p.ws + WS_KT) + (size_t)(b * 8 + hk) * 32 * 8192;
    const bf16_t* VTg = (const bf16_t*)(p.ws + WS_VALT) + (size_t)bh * 32 * 8192;
    const float* gcg = (const float*)(p.ws + WS_GC) + (size_t)bh * SEQ;
    constexpr int BUF = 62720, GC_OFF = 62464, OL_OFF = 125440, SL_OFF = 160256;
    if (w >= 4) {
        const int lt = tid - 256, r16 = lt >> 4, c16 = (lt & 15) * 8, r8 = lt >> 3, c8 = (lt & 7) * 8;
        const bf16_t* proj = (const bf16_t*)(p.ws + WS_PROJ) + (size_t)b * SEQ * NPROJ + 4096 + h * 128 + c16;
        const f32x4 nw0 = *(const f32x4*)(p.norm_w + c16), nw1 = *(const f32x4*)(p.norm_w + c16 + 4);
        u32x4 rg[14]; f32x4 rgg = {0.f, 0.f, 0.f, 0.f};
#define SC_LOADS(n) do { if (lt < 16) rgg = *(const f32x4*)(gcg + (n) * 64 + 4 * lt); \
        _Pragma("unroll") for (int i = 0; i < 4; ++i) { rg[i] = *(const u32x4*)(KCg + (size_t)((n) * 64 + r16 + 16 * i) * 128 + c16); rg[4 + i] = *(const u32x4*)(QQg + (size_t)((n) * 64 + r16 + 16 * i) * 128 + c16); } \
        _Pragma("unroll") for (int i = 0; i < 2; ++i) rg[8 + i] = *(const u32x4*)(ATg + (size_t)(n) * 4096 + (r8 + 32 * i) * 64 + c8); \
        _Pragma("unroll") for (int i = 0; i < 4; ++i) rg[10 + i] = *(const u32x4*)(KTg + (size_t)(n) * 8192 + (r8 + 32 * i) * 64 + c8); } while (0)
#define SC_STORES(bi) do { LAS unsigned char* bb_ = lds + (bi) * BUF; if (lt < 16) *(LAS f32x4*)(bb_ + GC_OFF + 16 * lt) = rgg; \
        _Pragma("unroll") for (int i = 0; i < 4; ++i) { *(LAS u32x4*)(bb_ + ((r16 + 16 * i) * 136 + c16) * 2) = rg[i]; *(LAS u32x4*)(bb_ + 17408 + ((r16 + 16 * i) * 136 + c16) * 2) = rg[4 + i]; } \
        _Pragma("unroll") for (int i = 0; i < 2; ++i) *(LAS u32x4*)(bb_ + 34816 + ((r8 + 32 * i) * 72 + c8) * 2) = rg[8 + i]; \
        _Pragma("unroll") for (int i = 0; i < 4; ++i) *(LAS u32x4*)(bb_ + 44032 + ((r8 + 32 * i) * 72 + c8) * 2) = rg[10 + i]; } while (0)
        SC_LOADS(0); SC_STORES(0);
        __syncthreads();
        for (int it = 0; it <= 32; ++it) {
            u32x4 zr[4];
            if (it >= 1) {
#pragma unroll
                for (int i = 0; i < 4; ++i) zr[i] = *(const u32x4*)(proj + (size_t)((it - 1) * 64 + r16 + 16 * i) * NPROJ); }
            if (it + 1 < 32) SC_LOADS(it + 1);
            if (it >= 1) { const int ob = (it - 1) & 1; const LAS bf16_t* OL = (const LAS bf16_t*)(lds + OL_OFF + ob * 17408); const LAS float* SL = (const LAS float*)(lds + SL_OFF + ob * 1024);
#pragma unroll
                for (int i = 0; i < 4; ++i) { const int row = r16 + 16 * i; float o[8], z[8]; unpack8(*(const LAS u32x4*)(OL + row * 136 + c16), o); unpack8(zr[i], z);
                    const f32x4 sp = *(const LAS f32x4*)(SL + row * 4); const float rs = rsqrtf(((sp[0] + sp[1]) + (sp[2] + sp[3])) * (1.f / 128.f) + 1e-6f);
#pragma unroll
                    for (int j = 0; j < 8; ++j) o[j] = o[j] * rs * (j < 4 ? nw0[j] : nw1[j - 4]) * silu_f(z[j]);
                    *(u32x4*)(OG + ((size_t)b * SEQ + (it - 1) * 64 + row) * 2048 + h * 128 + c16) = pack8(o); } }
            if (it + 1 < 32) SC_STORES((it + 1) & 1);
            __syncthreads();
        }
#undef SC_LOADS
#undef SC_STORES
    } else {
        const int dv0 = 32 * w;
        f32x4 S[8][2];
#pragma unroll
        for (int kb = 0; kb < 8; ++kb) { S[kb][0] = (f32x4){0.f, 0.f, 0.f, 0.f}; S[kb][1] = (f32x4){0.f, 0.f, 0.f, 0.f}; }
        u32x2 vtc[4][2], vtn[4][2];
#pragma unroll
        for (int mt = 0; mt < 4; ++mt) { vtc[mt][0] = *(const u32x2*)(VTg + (size_t)(dv0 + fr) * 64 + 16 * mt + 4 * fq); vtc[mt][1] = *(const u32x2*)(VTg + (size_t)(dv0 + 16 + fr) * 64 + 16 * mt + 4 * fq); }
        __syncthreads();
        for (int it = 0; it <= 32; ++it) {
            if (it < 32) {
                const int nn = it + 1 < 32 ? it + 1 : it;
#pragma unroll
                for (int mt = 0; mt < 4; ++mt) { vtn[mt][0] = *(const u32x2*)(VTg + (size_t)nn * 8192 + (size_t)(dv0 + fr) * 64 + 16 * mt + 4 * fq); vtn[mt][1] = *(const u32x2*)(VTg + (size_t)nn * 8192 + (size_t)(dv0 + 16 + fr) * 64 + 16 * mt + 4 * fq); }
                const LAS bf16_t* KCl = (const LAS bf16_t*)(lds + (it & 1) * BUF); const LAS bf16_t* QQl = KCl + 8704; const LAS bf16_t* ATl = KCl + 17408; const LAS bf16_t* KTl = KCl + 22016;
                LAS bf16_t* OL = (LAS bf16_t*)(lds + OL_OFF + (it & 1) * 17408); LAS float* SL = (LAS float*)(lds + SL_OFF + (it & 1) * 1024);
                const LAS float* GCl = (const LAS float*)(lds + (it & 1) * BUF + GC_OFF);
                const float gl = GCl[63], egl = __expf(gl);
                bf16x8 Sb[4][2];
#pragma unroll
                for (int ks = 0; ks < 4; ++ks) { Sb[ks][0] = packB(S[2 * ks][0], S[2 * ks + 1][0]); Sb[ks][1] = packB(S[2 * ks][1], S[2 * ks + 1][1]); }
                u32x2 vb[4][2], vs[4][2];
#pragma unroll
                for (int mt = 0; mt < 4; ++mt) {
                    f32x4 pa = {0.f, 0.f, 0.f, 0.f}, pb = pa, qa = pa, qb = pa;
#pragma unroll
                    for (int ks = 0; ks < 4; ++ks) { const bf16x8 ak = lds2x4(KCl + (16 * mt + fr) * 136 + 32 * ks + 4 * fq), aq = lds2x4(QQl + (16 * mt + fr) * 136 + 32 * ks + 4 * fq);
                        pa = MFMA16(ak, Sb[ks][0], pa); pb = MFMA16(ak, Sb[ks][1], pb); qa = MFMA16(aq, Sb[ks][0], qa); qb = MFMA16(aq, Sb[ks][1], qb); }
                    const u32x2 v0 = vtc[mt][0], v1 = vtc[mt][1];
                    const f32x4 vn0 = (f32x4){bflo(v0.x), bfhi(v0.x), bflo(v0.y), bfhi(v0.y)} - pa, vn1 = (f32x4){bflo(v1.x), bfhi(v1.x), bflo(v1.y), bfhi(v1.y)} - pb;
                    const f32x4 gcr = *(const LAS f32x4*)(GCl + 16 * mt + 4 * fq);
                    f32x4 eg, dd;
#pragma unroll
                    for (int r = 0; r < 4; ++r) { eg[r] = __expf(gcr[r]); dd[r] = __expf(gl - gcr[r]); }
                    vb[mt][0] = (u32x2){pk2(vn0[0], vn0[1]), pk2(vn0[2], vn0[3])}; vb[mt][1] = (u32x2){pk2(vn1[0], vn1[1]), pk2(vn1[2], vn1[3])};
                    { const f32x4 s0 = vn0 * dd, s1 = vn1 * dd; vs[mt][0] = (u32x2){pk2(s0[0], s0[1]), pk2(s0[2], s0[3])}; vs[mt][1] = (u32x2){pk2(s1[0], s1[1]), pk2(s1[2], s1[3])}; }
                    f32x4 o0 = qa * eg, o1 = qb * eg;
#pragma unroll
                    for (int kk = 0; kk < 2; ++kk) if (2 * kk <= mt) { const bf16x8 aa = lds2x4(ATl + (16 * mt + fr) * 72 + 32 * kk + 4 * fq);
                        const u32x2 z2 = {0u, 0u}; const u32x2 h0 = (2 * kk + 1 <= mt) ? vb[2 * kk + 1][0] : z2, h1 = (2 * kk + 1 <= mt) ? vb[2 * kk + 1][1] : z2;
                        const u32x4 w0 = {vb[2 * kk][0].x, vb[2 * kk][0].y, h0.x, h0.y}, w1 = {vb[2 * kk][1].x, vb[2 * kk][1].y, h1.x, h1.y};
                        o0 = MFMA16(aa, __builtin_bit_cast(bf16x8, w0), o0); o1 = MFMA16(aa, __builtin_bit_cast(bf16x8, w1), o1); }
                    f32x4 sq = o0 * o0 + o1 * o1;
#pragma unroll
                    for (int r = 0; r < 4; ++r) { float sx = sq[r]; sx += __shfl_xor(sx, 1); sx += __shfl_xor(sx, 2); sx += __shfl_xor(sx, 4); sx += __shfl_xor(sx, 8); sq[r] = sx; }
#pragma unroll
                    for (int r = 0; r < 4; ++r) { const int row = 16 * mt + 4 * fq + r; LAS bf16_t* op = OL + row * 136 + dv0 + fr;
                        op[0] = (bf16_t)(pk2(o0[r], 0.f) & 0xffffu); op[16] = (bf16_t)(pk2(o1[r], 0.f) & 0xffffu);
                        if (fr == 0) SL[row * 4 + w] = sq[r]; }
                }
                bf16x8 Vs[2][2];
#pragma unroll
                for (int kk = 0; kk < 2; ++kk)
#pragma unroll
                    for (int ct = 0; ct < 2; ++ct) { const u32x4 wv = {vs[2 * kk][ct].x, vs[2 * kk][ct].y, vs[2 * kk + 1][ct].x, vs[2 * kk + 1][ct].y}; Vs[kk][ct] = __builtin_bit_cast(bf16x8, wv); }
#pragma unroll
                for (int kb = 0; kb < 8; ++kb) { S[kb][0] *= egl; S[kb][1] *= egl;
#pragma unroll
                    for (int kk = 0; kk < 2; ++kk) { const bf16x8 aa = lds2x4(KTl + (16 * kb + fr) * 72 + 32 * kk + 4 * fq);
                        S[kb][0] = MFMA16(aa, Vs[kk][0], S[kb][0]); S[kb][1] = MFMA16(aa, Vs[kk][1], S[kb][1]); } }
#pragma unroll
                for (int mt = 0; mt < 4; ++mt) { vtc[mt][0] = vtn[mt][0]; vtc[mt][1] = vtn[mt][1]; }
            }
            __syncthreads();
        }
        float* ps = p.out + O_PS + (size_t)bh * 16384;
#pragma unroll
        for (int kb = 0; kb < 8; ++kb)
#pragma unroll
            for (int r = 0; r < 4; ++r) { ps[(size_t)(16 * kb + 4 * fq + r) * 128 + dv0 + fr] = S[kb][0][r]; ps[(size_t)(16 * kb + 4 * fq + r) * 128 + dv0 + 16 + fr] = S[kb][1][r]; }
    }
}
DI void sample_item(const Params& p, int item, LAS float* sm, int gt  ) {
    const int sb = item >> 4, h = item & 15, hk = h >> 1, row = TP + sb;
    const bf16_t* proj = (const bf16_t*)(p.ws + WS_PROJ) + (size_t)row * NPROJ; const float* ba = (const float*)(p.ws + WS_BA) + (size_t)row * 32;
    const float* cs = p.st_conv + (size_t)sb * 3 * CONVD;
    LAS float* qv = sm; LAS float* kv = sm + 128; LAS float* vv = sm + 256; LAS float* red = sm + 384;
    LAS float* part = sm + 400;
    const int rg = gt >> 5, c4 = (gt & 31) * 4;
    const float* S0 = p.st_S + ((size_t)(sb * 16 + h) * 128 + rg * 16) * 128 + c4;
    f32x4 Sr[16];
#pragma unroll
    for (int r = 0; r < 16; ++r) Sr[r] = *(const f32x4*)(S0 + (size_t)r * 128);
    {
        const int c = gt < 128 ? hk * 128 + gt : 1024 + hk * 128 + (gt - 128);
        const float cur = bflo((unsigned)proj[c]); const float x0 = cs[c], x1 = cs[CONVD + c], x2 = cs[2 * CONVD + c];
        const float y = silu_f(p.conv_w[c] * x0 + p.conv_w[CONVD + c] * x1 + p.conv_w[2 * CONVD + c] * x2 + p.conv_w[3 * CONVD + c] * cur);
        sm[gt] = y;
        if ((h & 1) == 0) { float* so = p.out + O_SCONV + (size_t)sb * 3 * CONVD + c; so[0] = x1; so[CONVD] = x2; so[2 * CONVD] = cur; }
        if (gt < 128) { const int cv = 2048 + h * 128 + gt; const float cu = bflo((unsigned)proj[cv]); const float a0 = cs[cv], a1 = cs[CONVD + cv], a2 = cs[2 * CONVD + cv];
            vv[gt] = silu_f(p.conv_w[cv] * a0 + p.conv_w[CONVD + cv] * a1 + p.conv_w[2 * CONVD + cv] * a2 + p.conv_w[3 * CONVD + cv] * cu);
            float* so = p.out + O_SCONV + (size_t)sb * 3 * CONVD + cv; so[0] = a1; so[CONVD] = a2; so[2 * CONVD] = cu; }
    }
    __syncthreads();
    {
        const int gw = gt >> 6, l = gt & 63;
        if (gw < 3) { const float a0 = gw == 1 ? kv[l] : qv[l], a1 = gw == 1 ? kv[64 + l] : qv[64 + l], b0 = gw == 0 ? qv[l] : kv[l], b1 = gw == 0 ? qv[64 + l] : kv[64 + l];
            float s = a0 * b0 + a1 * b1;
#pragma unroll
            for (int o = 32; o >= 1; o >>= 1) s += __shfl_xor(s, o);
            if (l == 0) red[gw] = s; }
    }
    __syncthreads();
    const float qs = rsqrtf(red[0] + 1e-6f) * 0.08838834764831845f, ksc = rsqrtf(red[1] + 1e-6f), qk = red[2] * qs * ksc;
    const float beta = sigmoid_f(ba[h]), g = -__expf(p.A_log[h]) * softplus_f(ba[16 + h] + p.dt_bias[h]), eg = __expf(g);
    f32x4 ks4 = {0.f, 0.f, 0.f, 0.f}, qs4 = ks4;
#pragma unroll
    for (int r = 0; r < 16; ++r) { const float kr = kv[rg * 16 + r], qr = qv[rg * 16 + r]; ks4 += Sr[r] * kr; qs4 += Sr[r] * qr; }
    *(LAS f32x4*)(part + rg * 128 + c4) = ks4; *(LAS f32x4*)(part + 1024 + rg * 128 + c4) = qs4;
    __syncthreads();
    f32x4 kS = {0.f, 0.f, 0.f, 0.f}, qS = kS;
#pragma unroll
    for (int r = 0; r < 8; ++r) { kS += *(const LAS f32x4*)(part + r * 128 + c4); qS += *(const LAS f32x4*)(part + 1024 + r * 128 + c4); }
    kS *= ksc; qS *= qs;
    const f32x4 v4 = *(const LAS f32x4*)(vv + c4);
    const f32x4 vnew = (v4 - kS * eg) * beta;
    const f32x4 o4 = qS * eg + vnew * qk;
    float* S1 = p.out + O_SS + ((size_t)(sb * 16 + h) * 128 + rg * 16) * 128 + c4;
#pragma unroll
    for (int r = 0; r < 16; ++r) { const float kr = kv[rg * 16 + r] * ksc; *(f32x4*)(S1 + (size_t)r * 128) = Sr[r] * eg + vnew * kr; }
    if (rg == 0) {
        float s = (o4[0] * o4[0] + o4[1] * o4[1]) + (o4[2] * o4[2] + o4[3] * o4[3]);
#pragma unroll
        for (int o = 16; o >= 1; o >>= 1) s += __shfl_xor(s, o);
        const float rs = rsqrtf(s * (1.f / 128.f) + 1e-6f);
        const u32x2 zz = *(const u32x2*)(proj + 4096 + h * 128 + c4); const float z[4] = {bflo(zz.x), bfhi(zz.x), bflo(zz.y), bfhi(zz.y)};
        const f32x4 nw = *(const f32x4*)(p.norm_w + c4); float og[4];
#pragma unroll
        for (int j = 0; j < 4; ++j) og[j] = o4[j] * rs * nw[j] * silu_f(z[j]);
        u32x2 wv; wv.x = pk2(og[0], og[1]); wv.y = pk2(og[2], og[3]);
        *(u32x2*)((bf16_t*)p.out + (size_t)row * 2048 + h * 128 + c4) = wv;
    }
    __syncthreads();
}
DI void phase_scan(const Params& p, LAS unsigned char* lds) {
    const int G = gridDim.x, bx = blockIdx.x;
    const int half = G / 2 > 0 ? G / 2 : 1;
    if (bx < half) { for (int bh = bx; bh < 128; bh += half) { scan_bh(p, bh, lds); __syncthreads(); } }
    if (bx >= half || G == 1) {
        const int nb = G == 1 ? 1 : G - half, me = G == 1 ? 0 : bx - half; const int tids = otid(); const int grp = tids >> 8, gt = tids & 255;
        LAS float* sm = (LAS float*)lds + grp * 4096;
        for (int it = me * 2 + grp; it < 2048; it += nb * 2) sample_item(p, it, sm, gt);
    }
}

__global__ void __launch_bounds__(NTHR) mk_fwd(Params p_arg) {
    const Params& p = *(const Params*)__builtin_amdgcn_kernarg_segment_ptr();
    extern __shared__ __attribute__((aligned(16))) unsigned char lds_raw[];
    LAS unsigned char* lds = (LAS unsigned char*)lds_raw;
    cg::grid_group grid = cg::this_grid();
    const int G = gridDim.x, bx = blockIdx.x;
    const float* mod = (const float*)(p.ws + WS_MOD);
    bf16_t* U = (bf16_t*)(p.ws + WS_U); bf16_t* PROJ = (bf16_t*)(p.ws + WS_PROJ); bf16_t* H = PROJ; float* R = (float*)(p.ws + WS_R);
    const float* Y = p.out + O_Y;
#define SEAM(k) do { if ((k) + 1 < p.ph_hi) grid.sync(); } while (0)
#define IN(k) (p.ph_lo <= (k) && (k) < p.ph_hi)
    if (IN(0)) { phase0(p, lds); SEAM(0); }
    if (IN(1)) { phase_u0(p); SEAM(1); }
    if (IN(2)) { pg8::Gemm g{U, (const bf16_t*)(p.ws + WS_WT_IN), 1024, 1024, 1024, 0}; pg8::StaticOrder S; S.init(MP, INPAD, G, bx);
        pg8::EpiInProj E{PROJ, (float*)(p.ws + WS_BA)}; pg8::gemm_phase(lds, g, S, E); SEAM(2); }
    if (IN(3)) { phase_prep(p, lds); SEAM(3); }
    if (IN(4)) { phase_scan(p, lds); SEAM(4); }
    if (IN(5)) { pg8::Gemm g{(const bf16_t*)p.out, (const bf16_t*)(p.ws + WS_WT_OUT), 2048, 2048, 2048, 0}; pg8::StaticOrder S; S.init(MP, 1024, G, bx);
        pg8::EpiRes E{p.x_prompt, p.x_sample, mod + 2048, nullptr, R}; pg8::gemm_phase(lds, g, S, E); SEAM(5); }
    if (IN(6)) { phase_ln<1>(p, p.ln_g, p.ln_b, mod + 3072); SEAM(6); }
#pragma unroll
    for (int l = 0; l < 2; ++l) {
        const int pb = l == 0 ? 7 : 13;
        if (IN(pb)) { pg8::Gemm g{U, (const bf16_t*)(p.ws + WS_WT_UP) + (size_t)l * 5632 * 1024, 1024, 1024, 1024, 0}; pg8::StaticOrder S; S.init(MP, 5632, G, bx);
            pg8::EpiSwiGLU E{H}; pg8::gemm_phase(lds, g, S, E); SEAM(pb); }
        if (IN(pb + 1)) { pg8::Gemm g{H, (const bf16_t*)(p.ws + WS_WT_DOWN) + (size_t)l * 1024 * DFF, DFF, DFF, DFF, 0}; pg8::StaticOrder S; S.init(MP, 1024, G, bx);
            pg8::EpiRes E{Y, Y + (size_t)TP * D, mod + (size_t)l * NBC * 6144 + 5120, nullptr, R}; pg8::gemm_phase(lds, g, S, E); SEAM(pb + 1); }
        if (l == 0) {
            if (IN(9)) { phase_ln<0>(p, p.ln_g + 1024, p.ln_b + 1024, nullptr); SEAM(9); }
            if (IN(10)) { phase_pool(p); SEAM(10); }
            if (IN(11)) { pg8::Gemm g{U, (const bf16_t*)(p.ws + WS_WT_POOL), 1024, 256, 256, 512}; pg8::StaticOrder S; S.init(MP, 1024, G, bx);
                pg8::EpiRes E{Y, Y + (size_t)TP * D, mod + (size_t)NBC * 6144 + 2048, p.pool_scale, R}; pg8::gemm_phase(lds, g, S, E); SEAM(11); }
            if (IN(12)) { phase_ln<1>(p, p.ln_g + 2048, p.ln_b + 2048, mod + (size_t)NBC * 6144 + 3072); SEAM(12); }
        } else {
            if (IN(15)) { phase_ln<0>(p, p.ln_g + 3072, p.ln_b + 3072, nullptr); }
        }
    }
#undef SEAM
#undef IN
}

extern "C" void kernel_launch(void* const* d_in, const int* in_sizes, int n_in, void* d_out, int out_size, void* d_ws, size_t ws_size, hipStream_t stream) {
    static int grid = 0;
    if (grid == 0) {
        if (ws_size < WS_END) { fprintf(stderr, "kernel_launch: workspace too small: %zu < %zu\n", ws_size, (size_t)WS_END); grid = -1; return; }
        int dev = 0, cus = 0, per_cu = 0;
        hipGetDevice(&dev); hipDeviceGetAttribute(&cus, hipDeviceAttributeMultiprocessorCount, dev);
        if (hipFuncSetAttribute((const void*)mk_fwd, hipFuncAttributeMaxDynamicSharedMemorySize, LDS_BYTES) != hipSuccess) { fprintf(stderr, "kernel_launch: hipFuncSetAttribute failed\n"); grid = -1; return; }
        if (hipOccupancyMaxActiveBlocksPerMultiprocessor(&per_cu, (const void*)mk_fwd, NTHR, LDS_BYTES) != hipSuccess || per_cu < 1) { fprintf(stderr, "kernel_launch: occupancy query failed (%d)\n", per_cu); (void)hipGetLastError(); per_cu = 1; }
        grid = cus;
        fprintf(stderr, "kernel_launch: cus %d per_cu %d grid %d ws %zu\n", cus, per_cu, grid, ws_size);
    }
    if (grid < 0) return;
    Params p{};
    p.x_prompt = (const float*)d_in[0]; p.x_sample = (const float*)d_in[1]; p.c_prompt = (const float*)d_in[2]; p.c_sample = (const float*)d_in[3];
    p.st_S = (const float*)d_in[4]; p.st_conv = (const float*)d_in[5]; p.st_pool = (const float*)d_in[6]; p.ada_w = (const float*)d_in[7]; p.ada_b = (const float*)d_in[8];
    p.ln_g = (const float*)d_in[9]; p.ln_b = (const float*)d_in[10]; p.w_in = (const float*)d_in[11]; p.conv_w = (const float*)d_in[12]; p.A_log = (const float*)d_in[13];
    p.dt_bias = (const float*)d_in[14]; p.norm_w = (const float*)d_in[15]; p.w_out = (const float*)d_in[16]; p.pool_w = (const float*)d_in[17]; p.pool_scale = (const float*)d_in[18];
    p.w_up = (const float*)d_in[19]; p.w_down = (const float*)d_in[20];
    p.out = (float*)d_out; p.ws = (unsigned char*)d_ws; p.ph_lo = 0; p.ph_hi = 16;
    void* args[] = {&p};
    hipError_t e = hipLaunchCooperativeKernel((const void*)mk_fwd, dim3(grid), dim3(NTHR), args, LDS_BYTES, stream);
    if (e != hipSuccess) fprintf(stderr, "kernel_launch: cooperative launch failed: %s (grid %d)\n", hipGetErrorString(e), grid);
}
```
